# Optimizing an MI355X kernel written in HIP

```python
import jax
import jax.numpy as jnp
from jax import lax
import numpy as np

D_MODEL = 2048
BATCH = 2
SEQ = 4096
DEPTH = 1

N_DIR = 2
HG_HEADS = 8
HG_DK = 128
HG_DV = 128
HG_KW = HG_HEADS * HG_DK
HG_VW = HG_HEADS * HG_DV
HG_CHUNK = 64
RG_WIDTH = D_MODEL // 2
RG_BLOCKS = 8
RG_BW = RG_WIDTH // RG_BLOCKS
RG_CONV = 4
RG_C = 8.0
N_GROUPS = 4
EXPERTS_PER_GROUP = 8
N_EXPERTS = N_GROUPS * EXPERTS_PER_GROUP
TOP_K = 2
D_EXPERT = 1024
MOE_BLOCK = 128
EPS = 1e-6
IN_SPLITS = (HG_KW, HG_VW, HG_KW, HG_KW, HG_VW, RG_WIDTH, RG_WIDTH, D_MODEL, D_MODEL)
IN_COLS = 3 * HG_KW + 2 * HG_VW + 2 * RG_WIDTH + 2 * D_MODEL

kernel_name = 'hybrid_hgrn2_rglru_hmoe_encoder'


def rmsnorm(x, gain):
    xf = x.astype(jnp.float32)
    y = xf * lax.rsqrt(jnp.mean(xf * xf, axis=-1, keepdims=True) + EPS)
    return (y * gain.astype(jnp.float32)).astype(x.dtype)


def modulate(h, shift, scale):
    return h * (1 + scale[:, None, :]) + shift[:, None, :]


def align_dirs(t, seq_axis):
    return jnp.stack([t[0], jnp.flip(t[1], axis=seq_axis)])


def to_heads(t, n_heads):
    t = t.reshape(t.shape[:-1] + (n_heads, t.shape[-1] // n_heads))
    return jnp.swapaxes(t, -3, -2)


def hgrn2_chunk_scan(q, k, v, log_f):
    nd, b, h, s, dk = q.shape
    dv = v.shape[-1]
    nc = s // HG_CHUNK

    def to_chunks(t):
        t = t.astype(jnp.float32).reshape(nd, b, h, nc, HG_CHUNK, t.shape[-1])
        return jnp.moveaxis(t, 3, 0)

    lower = jnp.tril(jnp.ones((HG_CHUNK, HG_CHUNK), dtype=bool))

    def step(state, chunk):
        qc, kc, vc, lfc = chunk
        cum = jnp.cumsum(lfc, axis=-2)
        o_inter = jnp.einsum('...tk,...kv->...tv', qc * jnp.exp(cum), state)
        diff = cum[..., :, None, :] - cum[..., None, :, :]
        decay = jnp.exp(jnp.where(lower[:, :, None], diff, -jnp.inf))
        scores = jnp.einsum('...tk,...tsk,...sk->...ts', qc, decay, kc)
        o_intra = jnp.einsum('...ts,...sv->...tv', scores, vc)
        last = cum[..., -1:, :]
        k_dec = kc * jnp.exp(last - cum)
        new_state = (jnp.exp(last[..., 0, :])[..., None] * state
                     + jnp.einsum('...sk,...sv->...kv', k_dec, vc))
        return new_state, o_inter + o_intra

    state0 = jnp.zeros((nd, b, h, dk, dv), jnp.float32)
    _, out = lax.scan(step, state0, (to_chunks(q), to_chunks(k), to_chunks(v), to_chunks(log_f)))
    return jnp.moveaxis(out, 0, 3).reshape(nd, b, h, s, dv)


def hgrn2_branch(q_pre, i_pre, f_fwd, f_bwd, g_pre, lb, hg_norm):
    bsz, s, _ = q_pre.shape
    q = to_heads(jax.nn.silu(q_pre), HG_HEADS)
    v = to_heads(i_pre, HG_HEADS)
    lbb = lb[:, None, None, :]
    f = lbb + (1 - lbb) * jax.nn.sigmoid(jnp.stack([f_fwd, f_bwd]).astype(jnp.float32))
    log_f = to_heads(jnp.log(f), HG_HEADS)
    k = to_heads(1 - f, HG_HEADS)
    out = hgrn2_chunk_scan(align_dirs(jnp.stack([q, q]), 2), align_dirs(k, 2),
                           align_dirs(jnp.stack([v, v]), 2), align_dirs(log_f, 2))
    out = align_dirs(out, 2)
    o = jnp.swapaxes(out[0] + out[1], 1, 2)
    o = rmsnorm(o, hg_norm).reshape(bsz, s, HG_VW)
    return o * jax.nn.silu(g_pre)


def lru_combine(e1, e2):
    a1, b1 = e1
    a2, b2 = e2
    return a1 * a2, a2 * b1 + b2


def rg_lru_branch(x_pre, y_pre, conv_w, conv_b, w_a, b_a, w_x, b_x, lam):
    bsz, s, _ = x_pre.shape
    pad = (RG_CONV // 2, RG_CONV - 1 - RG_CONV // 2)
    xc = lax.conv_general_dilated(x_pre, conv_w[:, None, :].astype(x_pre.dtype), (1,), [pad],
                                  dimension_numbers=('NWC', 'WIO', 'NWC'),
                                  feature_group_count=RG_WIDTH) + conv_b
    xb = xc.reshape(bsz, s, RG_BLOCKS, RG_BW)
    r = jax.nn.sigmoid(jnp.einsum('bshi,zhij->zbshj', xb, w_a) + b_a[:, None, None])
    gi = jax.nn.sigmoid(jnp.einsum('bshi,zhij->zbshj', xb, w_x) + b_x[:, None, None])
    r = r.reshape(N_DIR, bsz, s, RG_WIDTH).astype(jnp.float32)
    gi = gi.reshape(N_DIR, bsz, s, RG_WIDTH)
    log_a = -RG_C * r * jax.nn.softplus(-lam.astype(jnp.float32))[:, None, None, :]
    a = jnp.exp(log_a)
    u = jnp.sqrt(-jnp.expm1(2.0 * log_a)) * (gi * xc[None])
    _, hs = lax.associative_scan(lru_combine, (align_dirs(a, 1), align_dirs(u, 1)), axis=2)
    hs = align_dirs(hs, 1)
    return (hs[0] + hs[1]) * jax.nn.gelu(y_pre)


def hybrid_mixer(h, w_in, lb, hg_norm, conv_w, conv_b, w_a, b_a, w_x, b_x, lam,
                 w_proj_a, w_proj_b, w_out):
    split_points = [int(p) for p in np.cumsum(IN_SPLITS)[:-1]]
    proj = h @ w_in
    q_pre, i_pre, f_fwd, f_bwd, g_pre, rx, ry, ga, gb = jnp.split(proj, split_points, axis=-1)
    y_a = hgrn2_branch(q_pre, i_pre, f_fwd, f_bwd, g_pre, lb, hg_norm) @ w_proj_a
    y_b = rg_lru_branch(rx, ry, conv_w, conv_b, w_a, b_a, w_x, b_x, lam) @ w_proj_b
    merged = jax.nn.sigmoid(ga) * y_a + jax.nn.sigmoid(gb) * y_b
    return merged @ w_out


def hier_moe(h, w_group, w_router, w_gate, w_up, w_down):
    bsz, s, d = h.shape
    n = bsz * s
    hf = h.reshape(n, d)
    hf32 = hf.astype(jnp.float32)
    group_logits = hf32 @ w_group.astype(jnp.float32)
    group_prob = jax.nn.softmax(group_logits, axis=-1)
    _, g_idx = lax.top_k(group_logits, 1)
    g_sel = g_idx[:, 0]
    p_group = jnp.max(group_prob, axis=-1)
    all_logits = jnp.einsum('nd,dge->nge', hf32, w_router.astype(jnp.float32))
    sel_logits = jnp.einsum('nge,ng->ne', all_logits, jax.nn.one_hot(g_sel, N_GROUPS, dtype=jnp.float32))
    top_vals, top_idx = lax.top_k(sel_logits, TOP_K)
    weights = p_group[:, None] * jax.nn.softmax(top_vals, axis=-1)
    expert_id = g_sel[:, None] * EXPERTS_PER_GROUP + top_idx

    a = n * TOP_K
    e_flat = expert_id.reshape(a)
    tok_flat = jnp.repeat(jnp.arange(n, dtype=jnp.int32), TOP_K)
    w_flat = weights.reshape(a)
    order = jnp.argsort(e_flat)
    e_sorted = e_flat[order]
    counts = jnp.bincount(e_flat, length=N_EXPERTS)
    padded = (counts + MOE_BLOCK - 1) // MOE_BLOCK * MOE_BLOCK
    starts = jnp.cumsum(counts) - counts
    pad_ends = jnp.cumsum(padded)
    pad_starts = pad_ends - padded
    dest = pad_starts[e_sorted] + (jnp.arange(a) - starts[e_sorted])
    p = ((a + MOE_BLOCK - 1) // MOE_BLOCK + N_EXPERTS) * MOE_BLOCK
    row_tok = jnp.full((p,), n, jnp.int32).at[dest].set(tok_flat[order])
    row_w = jnp.zeros((p,), jnp.float32).at[dest].set(w_flat[order])
    nb = p // MOE_BLOCK
    block_expert = jnp.minimum(jnp.searchsorted(pad_ends, jnp.arange(nb) * MOE_BLOCK, side='right'),
                               N_EXPERTS - 1)
    h_pad = jnp.concatenate([hf, jnp.zeros((1, d), hf.dtype)], axis=0)
    xs = h_pad[row_tok].reshape(nb, MOE_BLOCK, d)

    def expert_block(args):
        xb, e = args
        hid = jax.nn.silu(xb @ w_gate[e]) * (xb @ w_up[e])
        return hid @ w_down[e]

    ys = lax.map(expert_block, (xs, block_expert)).reshape(p, d)
    out = jax.ops.segment_sum(ys * row_w[:, None], row_tok, num_segments=n + 1)[:n]
    return out.reshape(bsz, s, d).astype(h.dtype)


def setup_inputs(seed: int = 0) -> dict:
    key = jax.random.key(seed)
    ks = jax.random.split(key, 32)
    f32 = jnp.float32
    L = DEPTH

    def nrm(k, shape, fan_in):
        return jax.random.normal(k, shape, f32) * fan_in ** -0.5

    def small(k, shape):
        return 0.01 * jax.random.normal(k, shape, f32)

    a0 = jax.random.uniform(ks[15], (L, N_DIR, RG_WIDTH), f32, minval=0.9, maxval=0.999)
    return {
        'x': jax.random.normal(ks[0], (BATCH, SEQ, D_MODEL), f32),
        'c': jax.random.normal(ks[1], (BATCH, D_MODEL), f32),
        'w_ada': nrm(ks[2], (L, D_MODEL, 6 * D_MODEL), D_MODEL),
        'b_ada': small(ks[3], (L, 6 * D_MODEL)),
        'norm1': 1.0 + small(ks[4], (L, D_MODEL)),
        'w_in': nrm(ks[5], (L, D_MODEL, IN_COLS), D_MODEL),
        'hg_lb': 0.5 * jax.random.normal(ks[6], (L + 1, N_DIR, HG_KW), f32),
        'hg_norm': 1.0 + small(ks[7], (L, HG_HEADS, HG_DV)),
        'rg_conv_w': nrm(ks[8], (L, RG_CONV, RG_WIDTH), RG_CONV),
        'rg_conv_b': small(ks[9], (L, RG_WIDTH)),
        'rg_w_a': nrm(ks[10], (L, N_DIR, RG_BLOCKS, RG_BW, RG_BW), RG_BW),
        'rg_b_a': small(ks[11], (L, N_DIR, RG_BLOCKS, RG_BW)),
        'rg_w_x': nrm(ks[12], (L, N_DIR, RG_BLOCKS, RG_BW, RG_BW), RG_BW),
        'rg_b_x': small(ks[13], (L, N_DIR, RG_BLOCKS, RG_BW)),
        'rg_lambda': jnp.log(a0) - jnp.log1p(-a0),
        'w_proj_a': nrm(ks[16], (L, HG_VW, D_MODEL), HG_VW),
        'w_proj_b': nrm(ks[17], (L, RG_WIDTH, D_MODEL), RG_WIDTH),
        'w_out': nrm(ks[18], (L, D_MODEL, D_MODEL), D_MODEL),
        'norm2': 1.0 + small(ks[19], (L, D_MODEL)),
        'w_group': nrm(ks[20], (L, D_MODEL, N_GROUPS), D_MODEL),
        'w_router': nrm(ks[21], (L, D_MODEL, N_GROUPS, EXPERTS_PER_GROUP), D_MODEL),
        'w_gate': nrm(ks[22], (L, N_EXPERTS, D_MODEL, D_EXPERT), D_MODEL),
        'w_up': nrm(ks[23], (L, N_EXPERTS, D_MODEL, D_EXPERT), D_MODEL),
        'w_down': nrm(ks[24], (L, N_EXPERTS, D_EXPERT, D_MODEL), D_EXPERT),
        'final_norm': 1.0 + small(ks[25], (D_MODEL,)),
    }


def reference(x, c, w_ada, b_ada, norm1, w_in, hg_lb, hg_norm, rg_conv_w, rg_conv_b,
              rg_w_a, rg_b_a, rg_w_x, rg_b_x, rg_lambda, w_proj_a, w_proj_b, w_out,
              norm2, w_group, w_router, w_gate, w_up, w_down, final_norm):
    lb_all = jnp.cumsum(jax.nn.softmax(hg_lb.astype(jnp.float32), axis=0), axis=0)
    cond = jax.nn.silu(c)
    for layer in range(DEPTH):
        mod = cond @ w_ada[layer] + b_ada[layer]
        shift1, scale1, gate1, shift2, scale2, gate2 = jnp.split(mod, 6, axis=-1)
        h = modulate(rmsnorm(x, norm1[layer]), shift1, scale1)
        mix = hybrid_mixer(h, w_in[layer], lb_all[layer], hg_norm[layer], rg_conv_w[layer],
                           rg_conv_b[layer], rg_w_a[layer], rg_b_a[layer], rg_w_x[layer],
                           rg_b_x[layer], rg_lambda[layer], w_proj_a[layer], w_proj_b[layer],
                           w_out[layer])
        x = x + gate1[:, None, :] * mix
        h = modulate(rmsnorm(x, norm2[layer]), shift2, scale2)
        x = x + gate2[:, None, :] * hier_moe(h, w_group[layer], w_router[layer], w_gate[layer],
                                             w_up[layer], w_down[layer])
    return rmsnorm(x, final_norm)
```

```cpp
#include <hip/hip_runtime.h>
#include <cstdio>
#include <cstdint>

#ifndef MK_N_LAUNCHES
#define MK_N_LAUNCHES 1
#endif

namespace pg8 {
#define PG8_LAS __attribute__((address_space(3)))
typedef unsigned short bf16_t;
typedef short bf16x8 __attribute__((ext_vector_type(8)));
typedef float f32x4 __attribute__((ext_vector_type(4)));
typedef unsigned u32x4 __attribute__((ext_vector_type(4)));
constexpr int BM = 256, BK = 64, HALF = 128, HTB = HALF * BK * 2  , STAGE_BYTES = 8 * HTB, NXCD = 8, WGM = 8;

__host__ __device__ __forceinline__ int lds_byte(int r, int c) { const int st = (r >> 4) * 2 + (c >> 5), rr = r & 15, cc = c & 31, ob = rr * 64 + cc * 2; return st * 1024 + (ob ^ (((ob >> 9) & 1) << 5)); }
__host__ __device__ __forceinline__ void stage_rc(int b, int& R, int& C) { const int st = b / 1024, sb = b % 1024, swz = sb ^ (((sb >> 9) & 1) << 5); R = (st >> 1) * 16 + swz / 64; C = (st & 1) * 32 + (swz % 64) / 2; }
__host__ __device__ __forceinline__ int perm32(int rho) { const int n = rho >> 4, i = rho & 15; return 8 * (i >> 2) + 4 * n + (i & 3); }

struct Unit { int pm, pn; };
struct Gemm { const bf16_t* A; const bf16_t* Bt; int M, N, K; };

struct StaticOrder {
    int nM, nN, nwg, G, c;
    __host__ __device__ void init(int M, int N, int G_, int c_) { nM = M / BM; nN = N / BM; nwg = nM * nN; G = G_; c = c_; }
    __host__ __device__ bool next(int i, Unit& u) const {
        const long L = (long)i * G + c; if (L >= nwg) return false;
        int wgid = (int)L; { const int q = nwg / NXCD, r = nwg % NXCD, xcd = wgid % NXCD, off = wgid / NXCD; wgid = (xcd < r ? xcd * (q + 1) : r * (q + 1) + (xcd - r) * q) + off; }
        const int nig = WGM * nN, gid = wgid / nig, fm = gid * WGM, gsz = (nM - fm) < WGM ? (nM - fm) : WGM;
        u.pm = fm + ((wgid % nig) % gsz); u.pn = (wgid % nig) / gsz; return true;
    }
    __device__ __forceinline__ void a_ready(const Unit&) const {}
    __device__ __forceinline__ void done(const Unit&) const {}
};

typedef float f32x2c __attribute__((ext_vector_type(2)));
typedef __bf16 bf16x2c __attribute__((ext_vector_type(2)));
__device__ __forceinline__ unsigned cvt_pk_bf16(float lo, float hi) { const f32x2c f = {lo, hi}; const bf16x2c v = __builtin_convertvector(f, bf16x2c); return __builtin_bit_cast(unsigned, v); }
typedef float f32x2 __attribute__((ext_vector_type(2)));

template <class Epi, class Sched, bool ALIGN_EPI = false, bool SP2 = false>
__device__ __forceinline__ void gemm_phase(PG8_LAS unsigned char* lds, const Gemm g, const Sched& S, const Epi& E, const int tid  ) {
    const int wid = __builtin_amdgcn_readfirstlane(tid >> 6), lane = tid & 63, wr = wid >> 2, wc = wid & 3, fr = lane & 15, fq = lane >> 4;
    const int K = g.K, nt = K / BK;
    unsigned voffA[2], voffB[2];
#pragma unroll
    for (int i = 0; i < 2; ++i) { int R, C; stage_rc(tid * 16 + i * 8192, R, C); const int Rb = Epi::PERM ? ((R & ~31) + perm32(R & 31)) : R;
        voffA[i] = (unsigned)(R * K + C) * 2u; voffB[i] = (unsigned)(Rb * K + C) * 2u; }
    const size_t kstep = (size_t)(BK * 2);
    const size_t hstep = (size_t)HALF * K * 2;
    const size_t tstep = 2 * hstep;
    const unsigned ldsw = (unsigned)wid * 1024u;
    const int aoff = lds_byte(wr * 64 + fr, fq * 8), boff = lds_byte(wc * 32 + fr, fq * 8);
#define PG8_SA(b, h) (((b) * 2 + (h)) * HTB)
#define PG8_SB(b, h) ((4 + (b) * 2 + (h)) * HTB)
#define PG8_STAGE(bufoff, gbase, voff) do { _Pragma("unroll") for (int _i = 0; _i < 2; ++_i) \
        __builtin_amdgcn_global_load_lds((const unsigned*)((const char*)(gbase) + (voff)[_i]), (PG8_LAS unsigned*)(lds + (bufoff) + ldsw + _i * 8192), 16, 0, 0); } while (0)
#define PG8_LDA(dst, b, h) do { _Pragma("unroll") for (int m = 0; m < 4; ++m) _Pragma("unroll") for (int k = 0; k < 2; ++k) dst[m][k] = *(const PG8_LAS bf16x8*)(lds + PG8_SA(b, h) + aoff + m * 2048 + k * 1024); } while (0)
#define PG8_LDB(dst, b, h) do { _Pragma("unroll") for (int n = 0; n < 2; ++n) _Pragma("unroll") for (int k = 0; k < 2; ++k) dst[n][k] = *(const PG8_LAS bf16x8*)(lds + PG8_SB(b, h) + boff + n * 2048 + k * 1024); } while (0)
#define PG8_MMA(ai, bj, At, Bt) do { __builtin_amdgcn_s_setprio(1); _Pragma("unroll") for (int m = 0; m < 4; ++m) _Pragma("unroll") for (int n = 0; n < 2; ++n) _Pragma("unroll") for (int k = 0; k < 2; ++k) \
        acc[ai][bj][m][n] = __builtin_amdgcn_mfma_f32_16x16x32_bf16(Bt[n][k], At[m][k], acc[ai][bj][m][n], 0, 0, 0); __builtin_amdgcn_s_setprio(0); } while (0)
#define PG8_WAIT_V(n) asm volatile("s_waitcnt vmcnt(" #n ")" ::: "memory")
#define PG8_WAIT_L(n) asm volatile("s_waitcnt lgkmcnt(" #n ")" ::: "memory")
#define PG8_BAR __builtin_amdgcn_s_barrier()
#define PG8_SCHED __builtin_amdgcn_sched_barrier(0)
    Unit cur, nxt; int ui = 0;
    if (!S.next(0, cur)) return;
    f32x4 acc[2][2][4][2];
#pragma unroll
    for (int a = 0; a < 2; ++a)
#pragma unroll
        for (int b = 0; b < 2; ++b)
#pragma unroll
            for (int m = 0; m < 4; ++m)
#pragma unroll
                for (int n = 0; n < 2; ++n) acc[a][b][m][n] = (f32x4){0.f, 0.f, 0.f, 0.f};
    bf16x8 At[4][2], B0[2][2], B1[2][2];
    const char* cA = (const char*)g.A + (size_t)cur.pm * tstep; const char* cB = (const char*)g.Bt + (size_t)cur.pn * tstep;
    S.a_ready(cur);
    if constexpr (SP2) {
        PG8_STAGE(PG8_SB(0, 0), cB, voffB); PG8_STAGE(PG8_SB(0, 1), cB + hstep, voffB); PG8_STAGE(PG8_SA(0, 0), cA, voffA); PG8_STAGE(PG8_SA(0, 1), cA + hstep, voffA);
        if (wr == 1) PG8_BAR;
        PG8_WAIT_V(2); PG8_BAR;
        PG8_STAGE(PG8_SB(1, 0), cB + kstep, voffB); PG8_STAGE(PG8_SA(1, 0), cA + kstep, voffA); PG8_STAGE(PG8_SB(1, 1), cB + hstep + kstep, voffB);
        PG8_WAIT_V(6); PG8_BAR;
    } else {
        PG8_STAGE(PG8_SB(0, 0), cB, voffB); PG8_STAGE(PG8_SA(0, 0), cA, voffA); PG8_STAGE(PG8_SB(0, 1), cB + hstep, voffB); PG8_STAGE(PG8_SA(0, 1), cA + hstep, voffA);
        if (wr == 1) PG8_BAR;
        PG8_WAIT_V(4); PG8_BAR;
        PG8_STAGE(PG8_SB(1, 0), cB + kstep, voffB); PG8_STAGE(PG8_SA(1, 0), cA + kstep, voffA); PG8_STAGE(PG8_SB(1, 1), cB + hstep + kstep, voffB);
        PG8_WAIT_V(6); PG8_BAR;
    }
    for (;;) {
        const bool has_next = S.next(ui + 1, nxt);
        const char* nA = has_next ? (const char*)g.A + (size_t)nxt.pm * tstep : cA; const char* nB = has_next ? (const char*)g.Bt + (size_t)nxt.pn * tstep : cB;
        for (int t = 0; t < nt; t += 2) {
            const bool last = (t == nt - 2);
            const char* a1 = cA + (size_t)(t + 1) * kstep;
            const char* a2 = last ? nA : cA + (size_t)(t + 2) * kstep; const char* b2 = last ? nB : cB + (size_t)(t + 2) * kstep;
            const char* a3 = a2 + kstep; const char* b3 = b2 + kstep;
            if (last && has_next) S.a_ready(nxt);
            if constexpr (SP2) {
            PG8_LDB(B0, 0, 0); PG8_LDB(B1, 0, 1); PG8_SCHED; PG8_LDA(At, 0, 0); PG8_STAGE(PG8_SA(1, 1), a1 + hstep, voffA);
            PG8_WAIT_V(8); PG8_WAIT_L(0); PG8_BAR; PG8_MMA(0, 0, At, B0); PG8_MMA(0, 1, At, B1); PG8_BAR; PG8_SCHED;
            PG8_LDA(At, 0, 1); PG8_STAGE(PG8_SB(0, 0), b2, voffB); PG8_STAGE(PG8_SB(0, 1), b2 + hstep, voffB); PG8_STAGE(PG8_SA(0, 0), a2, voffA);
            PG8_WAIT_V(8); PG8_WAIT_L(0); PG8_BAR; PG8_MMA(1, 0, At, B0); PG8_MMA(1, 1, At, B1); PG8_BAR; PG8_SCHED;
            PG8_LDB(B0, 1, 0); PG8_LDB(B1, 1, 1); PG8_SCHED; PG8_LDA(At, 1, 0); PG8_STAGE(PG8_SA(0, 1), a2 + hstep, voffA);
            PG8_WAIT_V(8); PG8_WAIT_L(0); PG8_BAR; PG8_MMA(0, 0, At, B0); PG8_MMA(0, 1, At, B1); PG8_BAR; PG8_SCHED;
            PG8_LDA(At, 1, 1); PG8_STAGE(PG8_SB(1, 0), b3, voffB); PG8_STAGE(PG8_SB(1, 1), b3 + hstep, voffB); PG8_STAGE(PG8_SA(1, 0), a3, voffA);
            PG8_WAIT_V(8); PG8_WAIT_L(0); PG8_BAR; PG8_MMA(1, 0, At, B0); PG8_MMA(1, 1, At, B1); PG8_BAR; PG8_SCHED;
            } else {
            PG8_LDB(B0, 0, 0); PG8_SCHED; PG8_LDA(At, 0, 0); PG8_STAGE(PG8_SA(1, 1), a1 + hstep, voffA);
            PG8_WAIT_L(8); PG8_BAR; PG8_WAIT_L(0); PG8_MMA(0, 0, At, B0); PG8_BAR; PG8_SCHED;
            PG8_LDB(B1, 0, 1); PG8_STAGE(PG8_SB(0, 0), b2, voffB);
            PG8_BAR; PG8_WAIT_L(0); PG8_MMA(0, 1, At, B1); PG8_BAR;
            PG8_LDA(At, 0, 1); PG8_STAGE(PG8_SA(0, 0), a2, voffA);
            PG8_BAR; PG8_WAIT_L(0); PG8_MMA(1, 0, At, B0); PG8_BAR; PG8_SCHED;
            PG8_STAGE(PG8_SB(0, 1), b2 + hstep, voffB);
            PG8_WAIT_V(6); PG8_BAR; PG8_MMA(1, 1, At, B1); PG8_BAR;
            PG8_LDB(B0, 1, 0); PG8_SCHED; PG8_LDA(At, 1, 0); PG8_STAGE(PG8_SA(0, 1), a2 + hstep, voffA);
            PG8_WAIT_L(8); PG8_BAR; PG8_WAIT_L(0); PG8_MMA(0, 0, At, B0); PG8_BAR; PG8_SCHED;
            PG8_LDB(B1, 1, 1); PG8_STAGE(PG8_SB(1, 0), b3, voffB);
            PG8_BAR; PG8_WAIT_L(0); PG8_MMA(0, 1, At, B1); PG8_BAR;
            PG8_LDA(At, 1, 1); PG8_STAGE(PG8_SA(1, 0), a3, voffA);
            PG8_BAR; PG8_WAIT_L(0); PG8_MMA(1, 0, At, B0); PG8_BAR; PG8_SCHED;
            PG8_STAGE(PG8_SB(1, 1), b3 + hstep, voffB);
            PG8_WAIT_V(6); PG8_BAR; PG8_MMA(1, 1, At, B1); PG8_BAR;
            }
        }
        if constexpr (ALIGN_EPI) { if (wr == 0) PG8_BAR; }
        if constexpr (!Epi::AFTER_DRAIN) { E(acc, cur, wr, wc, fr, fq); S.done(cur); }
        if (!has_next) break;
#pragma unroll
        for (int a = 0; a < 2; ++a)
#pragma unroll
            for (int b = 0; b < 2; ++b)
#pragma unroll
                for (int m = 0; m < 4; ++m)
#pragma unroll
                    for (int n = 0; n < 2; ++n) acc[a][b][m][n] = (f32x4){0.f, 0.f, 0.f, 0.f};
        cur = nxt; cA = nA; cB = nB; ++ui;
        if constexpr (ALIGN_EPI) { if (wr == 1) PG8_BAR; }
    }
    PG8_WAIT_V(0);
    if constexpr (!ALIGN_EPI) { if (wr == 0) PG8_BAR; }
    PG8_BAR;
    if constexpr (Epi::AFTER_DRAIN) { E.fused(acc, cur, wr, wc, fr, fq, lds, wid, lane); S.done(cur); }
#undef PG8_SA
#undef PG8_SB
#undef PG8_STAGE
#undef PG8_LDA
#undef PG8_LDB
#undef PG8_MMA
#undef PG8_WAIT_V
#undef PG8_WAIT_L
#undef PG8_BAR
#undef PG8_SCHED
}
}

constexpr int NTOK = 8192, SEQ = 4096, DM = 2048, INC = 11264, HW = 1024, NEXP = 32, DEX = 1024;
constexpr float EPS = 1e-6f;
constexpr int NWAVES = 8, NTHR = 512;

constexpr size_t MiB = 1u << 20;
constexpr size_t WS_CTL = 0, CTL_ZERO_BYTES = 65536;
constexpr size_t WS_MOD = 1 * MiB;
constexpr size_t WS_LB = 1 * MiB + 128 * 1024;
constexpr size_t WS_UTAB = 1 * MiB + 256 * 1024;
constexpr size_t WS_TOKE = 2 * MiB;
constexpr size_t WS_TOKW = 2 * MiB + 64 * 1024;
constexpr size_t WS_TOKP = 2 * MiB + 128 * 1024;
constexpr size_t WS_RTOK = 2 * MiB + 256 * 1024;
constexpr size_t WS_BIAS2 = 1 * MiB + 192 * 1024;
constexpr size_t WS_WR2 = 3 * MiB;
constexpr size_t WS_WIN = 4 * MiB;
constexpr size_t WS_WPA = 48 * MiB, WS_WPB = 52 * MiB, WS_WOUT = 56 * MiB;
constexpr size_t WS_H = 448 * MiB;
constexpr size_t WS_X1 = 480 * MiB;
constexpr size_t WS_Q = 544 * MiB, WS_V = 560 * MiB, WS_GF = 576 * MiB, WS_GB = 608 * MiB, WS_GOUT = 640 * MiB, WS_RGX = 656 * MiB, WS_RGY = 672 * MiB, WS_SGA = 688 * MiB, WS_SGB = 720 * MiB;
constexpr size_t WS_HGO = 752 * MiB, WS_RGO = 768 * MiB, WS_YA = 784 * MiB, WS_MRG = 816 * MiB;
constexpr size_t WS_SA = 848 * MiB, WS_SU = 912 * MiB;
constexpr size_t WS_HID = 640 * MiB;
constexpr size_t WS_Y = 688 * MiB;
constexpr size_t WS_HL = 914 * MiB;
constexpr size_t WS_PP = 946 * MiB;
constexpr size_t WS_AE = 978 * MiB;
constexpr size_t WS_CIN = 980 * MiB;
constexpr size_t WS_WG = 981 * MiB;
constexpr size_t WS_END = 982 * MiB;
constexpr int CW_BAR = 4096, CW_NU = 8320, CW_RANK = 8448, CW_HID = 9600, CW_MODC = 9900  ;

constexpr int RING_BYTES = 131072, MISC_OFF = RING_BYTES + 320, LDS_BYTES = 147456;

#define GAS __attribute__((address_space(1)))
#define LAS __attribute__((address_space(3)))
typedef unsigned short bf16;
typedef float f32x4 __attribute__((ext_vector_type(4)));
typedef unsigned u32x4 __attribute__((ext_vector_type(4)));
typedef unsigned u32x2 __attribute__((ext_vector_type(2)));
#define LDS_WAIT() asm volatile("s_waitcnt lgkmcnt(0)" ::: "memory")
__device__ __forceinline__ float bf2f(unsigned b) { return __uint_as_float(b << 16); }
__device__ __forceinline__ float bflo(unsigned w) { return __uint_as_float(w << 16); }
__device__ __forceinline__ float bfhi(unsigned w) { return __uint_as_float(w & 0xffff0000u); }
__device__ __forceinline__ unsigned pk2(float lo, float hi) { return pg8::cvt_pk_bf16(lo, hi); }
__device__ __forceinline__ float fsigmoid(float x) { return __builtin_amdgcn_rcpf(1.f + __expf(-x)); }
__device__ __forceinline__ float fsilu(float x) { return x * fsigmoid(x); }
__device__ __forceinline__ float fgelu_tanh(float x) { const float u = 0.7978845608028654f * (x + 0.044715f * x * x * x); return x * fsigmoid(2.f * u); }
__device__ __forceinline__ float wave_sum(float v) {
#pragma unroll
    for (int o = 1; o < 64; o <<= 1) v += __shfl_xor(v, o);
    return v;
}

#define XB_TMO      128
#define XB_XCNT(j)  (256  + 64 * (j))
#define XB_XSUB(j)  (1280 + 64 * (j))
#define XB_XGEN(j)  (2304 + 64 * (j))
#define XB_TOP      3328
#define XB_TOPGEN   3392
#define XCD_BAR_WORDS 3456
#define XB_SPIN_CAP (1u << 18)
__device__ __forceinline__ unsigned xb_ld(unsigned* p)              { return __hip_atomic_load(p, __ATOMIC_RELAXED, __HIP_MEMORY_SCOPE_AGENT); }
__device__ __forceinline__ unsigned xb_add(unsigned* p, unsigned v) { return __hip_atomic_fetch_add(p, v, __ATOMIC_RELAXED, __HIP_MEMORY_SCOPE_AGENT); }
__device__ __forceinline__ unsigned xb_xcc_id() { return (unsigned)__builtin_amdgcn_s_getreg((3 << 11) | 20) & 0xFu; }
#define XB_SPIN(cond, bar) do { unsigned _sp = 0; while (cond) { __builtin_amdgcn_s_sleep(1); \
    if ((++_sp & 255u) == 0u) { if (xb_ld(&(bar)[XB_TMO])) break; if (_sp > XB_SPIN_CAP) { atomicAdd(&(bar)[XB_TMO], 1u); break; } } } } while (0)
struct XcdBarrier { unsigned* bar; unsigned x; volatile LAS unsigned* st; };
__device__ __forceinline__ XcdBarrier xcd_barrier_post(unsigned* bar, volatile LAS unsigned* st) {
    XcdBarrier b; b.bar = bar; b.x = xb_xcc_id(); b.st = st;
    if (threadIdx.x == 0) (void)xb_add(&bar[XB_XCNT(b.x)], 1u);
    return b;
}
__device__ __forceinline__ void xcd_barrier_complete(unsigned* bar, unsigned x, unsigned& nloc, unsigned& nx) {
    const unsigned G = gridDim.x * gridDim.y * gridDim.z;
    unsigned sum, cnt, mine, sp = 0u;
    for (;;) {
        sum = 0u; cnt = 0u; mine = 0u;
#pragma unroll
        for (unsigned j = 0; j < 16; ++j) { const unsigned c = xb_ld(&bar[XB_XCNT(j)]); sum += c; cnt += (c > 0u) ? 1u : 0u; mine = (j == x) ? c : mine; }
        if (sum == G) break;
        __builtin_amdgcn_s_sleep(1);
        if ((++sp & 255u) == 0u) { if (xb_ld(&bar[XB_TMO])) break; if (sp > XB_SPIN_CAP) { atomicAdd(&bar[XB_TMO], 1u); break; } }
    }
    nloc = mine > 0u ? mine : 1u; nx = cnt > 0u ? cnt : 1u;
}
__device__ __forceinline__ void xcd_barrier(const XcdBarrier& b, int tid) {
    asm volatile("s_waitcnt vmcnt(0)" ::: "memory");
    __syncthreads();
    if (tid == 0) {
        unsigned* bar = b.bar;
        __builtin_amdgcn_s_waitcnt(0);
        unsigned nloc = b.st[0], nx = b.st[1];
        if (nloc == 0u) { xcd_barrier_complete(bar, b.x, nloc, nx); b.st[0] = nloc; b.st[1] = nx; }
        const unsigned old = xb_add(&bar[XB_XSUB(b.x)], 1u);
        const unsigned gen = old / nloc;
        if (old + 1u == (gen + 1u) * nloc) {
            __builtin_amdgcn_fence(__ATOMIC_RELEASE, "agent");
            asm volatile("s_waitcnt vmcnt(0)" ::: "memory");
            const unsigned og = xb_add(&bar[XB_TOP], 1u);
            const unsigned tg = og / nx;
            if (og + 1u == (tg + 1u) * nx) xb_add(&bar[XB_TOPGEN], 1u);
            else XB_SPIN(xb_ld(&bar[XB_TOPGEN]) == tg, bar);
            __builtin_amdgcn_fence(__ATOMIC_ACQUIRE, "agent");
            xb_add(&bar[XB_XGEN(b.x)], 1u);
            asm volatile("s_waitcnt vmcnt(0)" ::: "memory");
        } else {
            XB_SPIN(xb_ld(&bar[XB_XGEN(b.x)]) == gen, bar);
            __builtin_amdgcn_fence(__ATOMIC_ACQUIRE, "agent");
            asm volatile("s_waitcnt vmcnt(0)" ::: "memory");
        }
    }
    __syncthreads();
}

struct Args { const float* in[25]; float* out; unsigned char* ws; int ph_lo, ph_hi; };
enum { I_X = 0, I_C, I_WADA, I_BADA, I_NORM1, I_WIN, I_HGLB, I_HGNORM, I_CONVW, I_CONVB, I_RGWA, I_RGBA, I_RGWX, I_RGBX, I_LAM, I_WPA, I_WPB, I_WOUT, I_NORM2, I_WGRP, I_WRTR, I_WGATE, I_WUP, I_WDOWN, I_FNORM };
struct Ctx { LAS unsigned char* lds; int tid, lane, wave, bid, G, gw, NGW, vb; };

struct EpiIn {
    static constexpr bool PERM = true, AFTER_DRAIN = false;
    unsigned char* ws; const float* LB;
    template <int MODE> __device__ __forceinline__ void body(const f32x4 (&acc)[2][2][4][2], void* basev, int ldc, int row0, int col0, const float* lbp) const {
        f32x4 lb[2][2];
        if (MODE == 2) {
#pragma unroll
            for (int bj = 0; bj < 2; ++bj)
#pragma unroll
                for (int n = 0; n < 2; ++n) lb[bj][n] = *(const f32x4*)(lbp + col0 + bj * 128 + 4 * n);
        }
#pragma unroll
        for (int ai = 0; ai < 2; ++ai)
#pragma unroll
            for (int m = 0; m < 4; ++m) {
                const size_t ro = (size_t)(row0 + ai * 128 + m * 16) * ldc + col0;
#pragma unroll
                for (int bj = 0; bj < 2; ++bj) {
                    f32x4 v0 = acc[ai][bj][m][0], v1 = acc[ai][bj][m][1];
                    if (MODE == 2) {
#pragma unroll
                        for (int j = 0; j < 4; ++j) { const float l0 = lb[bj][0][j], l1 = lb[bj][1][j];
                            v0[j] = __logf(l0 + (1.f - l0) * fsigmoid(v0[j])); v1[j] = __logf(l1 + (1.f - l1) * fsigmoid(v1[j])); }
                        float* p = (float*)basev + ro + bj * 128;
                        *(f32x4*)p = v0; *(f32x4*)(p + 4) = v1;
                    } else {
#pragma unroll
                        for (int j = 0; j < 4; ++j) {
                            if (MODE == 0) { v0[j] = fsilu(v0[j]); v1[j] = fsilu(v1[j]); }
                            if (MODE == 3) { v0[j] = fgelu_tanh(v0[j]); v1[j] = fgelu_tanh(v1[j]); }
                            if (MODE == 4) { v0[j] = fsigmoid(v0[j]); v1[j] = fsigmoid(v1[j]); }
                        }
                        u32x4 w; w.x = pk2(v0[0], v0[1]); w.y = pk2(v0[2], v0[3]); w.z = pk2(v1[0], v1[1]); w.w = pk2(v1[2], v1[3]);
                        *(u32x4*)((bf16*)basev + ro + bj * 128) = w;
                    }
                }
            }
    }
    __device__ __forceinline__ void operator()(const f32x4 (&acc)[2][2][4][2], const pg8::Unit& u, int wr, int wc, int fr, int fq) const {
        const int row0 = u.pm * 256 + wr * 64 + fr, pn = u.pn, cl = wc * 32 + 8 * fq;
        if (pn < 4)       body<0>(acc, ws + WS_Q, 1024, row0, pn * 256 + cl, nullptr);
        else if (pn < 8)  body<1>(acc, ws + WS_V, 1024, row0, (pn - 4) * 256 + cl, nullptr);
        else if (pn < 12) body<2>(acc, ws + WS_GF, 1024, row0, (pn - 8) * 256 + cl, LB);
        else if (pn < 16) body<2>(acc, ws + WS_GB, 1024, row0, (pn - 12) * 256 + cl, LB + 1024);
        else if (pn < 20) body<0>(acc, ws + WS_GOUT, 1024, row0, (pn - 16) * 256 + cl, nullptr);
        else if (pn < 24) body<1>(acc, ws + WS_RGX, 1024, row0, (pn - 20) * 256 + cl, nullptr);
        else if (pn < 28) body<3>(acc, ws + WS_RGY, 1024, row0, (pn - 24) * 256 + cl, nullptr);
        else              body<4>(acc, ws + (pn < 36 ? WS_SGA : WS_SGB), 2048, row0, ((pn - 28) & 7) * 256 + cl, nullptr);
    }
};
template <int MODE> struct EpiGate {
    static constexpr bool PERM = true, AFTER_DRAIN = false;
    const bf16* Gm; const bf16* P; bf16* O; int ldc;
    __device__ __forceinline__ void operator()(const f32x4 (&acc)[2][2][4][2], const pg8::Unit& u, int wr, int wc, int fr, int fq) const {
        const int row0 = u.pm * 256 + wr * 64 + fr, col0 = u.pn * 256 + wc * 32 + 8 * fq;
#pragma unroll
        for (int ai = 0; ai < 2; ++ai)
#pragma unroll
            for (int m = 0; m < 4; ++m) {
                const size_t ro = (size_t)(row0 + ai * 128 + m * 16) * ldc + col0;
#pragma unroll
                for (int bj = 0; bj < 2; ++bj) {
                    const u32x4 g = *(const u32x4*)(Gm + ro + bj * 128);
                    f32x4 v0 = acc[ai][bj][m][0], v1 = acc[ai][bj][m][1];
                    v0[0] *= bflo(g.x); v0[1] *= bfhi(g.x); v0[2] *= bflo(g.y); v0[3] *= bfhi(g.y);
                    v1[0] *= bflo(g.z); v1[1] *= bfhi(g.z); v1[2] *= bflo(g.w); v1[3] *= bfhi(g.w);
                    if (MODE == 1) { const u32x4 p = *(const u32x4*)(P + ro + bj * 128);
                        v0[0] += bflo(p.x); v0[1] += bfhi(p.x); v0[2] += bflo(p.y); v0[3] += bfhi(p.y);
                        v1[0] += bflo(p.z); v1[1] += bfhi(p.z); v1[2] += bflo(p.w); v1[3] += bfhi(p.w); }
                    u32x4 w; w.x = pk2(v0[0], v0[1]); w.y = pk2(v0[2], v0[3]); w.z = pk2(v1[0], v1[1]); w.w = pk2(v1[2], v1[3]);
                    *(u32x4*)(O + ro + bj * 128) = w;
                }
            }
    }
};
struct EpiX1 {
    static constexpr bool PERM = false, AFTER_DRAIN = false;
    const float* x; const float* mod; float* X1;
    __device__ __forceinline__ void operator()(const f32x4 (&acc)[2][2][4][2], const pg8::Unit& u, int wr, int wc, int fr, int fq) const {
        const int row0 = u.pm * 256 + wr * 64 + fr, col0 = u.pn * 256 + wc * 32 + 4 * fq;
        const float* g1 = mod + (size_t)((u.pm * 256) >> 12) * 12288 + 2 * DM;
        f32x4 gv[2][2];
#pragma unroll
        for (int bj = 0; bj < 2; ++bj)
#pragma unroll
            for (int n = 0; n < 2; ++n) gv[bj][n] = *(const f32x4*)(g1 + col0 + bj * 128 + n * 16);
#pragma unroll
        for (int ai = 0; ai < 2; ++ai)
#pragma unroll
            for (int m = 0; m < 4; ++m) {
                const size_t ro = (size_t)(row0 + ai * 128 + m * 16) * DM + col0;
#pragma unroll
                for (int bj = 0; bj < 2; ++bj)
#pragma unroll
                    for (int n = 0; n < 2; ++n) { const f32x4 xv = *(const f32x4*)(x + ro + bj * 128 + n * 16);
                        *(f32x4*)(X1 + ro + bj * 128 + n * 16) = xv + gv[bj][n] * acc[ai][bj][m][n]; }
            }
    }
};
__device__ __forceinline__ void transpose_item(const float* W, int K, int N, bf16* WT, int k0, int n0, size_t dst_row0, LAS float* scr, int lane) {
    f32x4 v[8];
#pragma unroll
    for (int i = 0; i < 8; ++i) v[i] = *(const f32x4*)(W + (size_t)(k0 + (lane >> 3) + 8 * i) * N + n0 + 4 * (lane & 7));
#pragma unroll
    for (int i = 0; i < 8; ++i) { LAS float* d = scr + ((lane >> 3) + 8 * i) * 33 + 4 * (lane & 7); d[0] = v[i][0]; d[1] = v[i][1]; d[2] = v[i][2]; d[3] = v[i][3]; }
    LDS_WAIT(); asm volatile("" ::: "memory");
    const int c = lane & 7;
#pragma unroll
    for (int j = 0; j < 4; ++j) { const int n = (lane >> 3) + 8 * j; const LAS float* s = scr + (8 * c) * 33 + n;
        u32x4 o; o.x = pk2(s[0 * 33], s[1 * 33]); o.y = pk2(s[2 * 33], s[3 * 33]); o.z = pk2(s[4 * 33], s[5 * 33]); o.w = pk2(s[6 * 33], s[7 * 33]);
        *(u32x4*)(WT + (dst_row0 + n) * K + k0 + 8 * c) = o; }
    LDS_WAIT(); asm volatile("" ::: "memory");
}

constexpr int CV_I0 = 32 * 352, CV_I1 = 16 * 64, CV_I3 = 32 * 64, CV_ALL = CV_I0 + 2 * CV_I1 + CV_I3;
__device__ __forceinline__ void convert_items(const Args& a, LAS unsigned char* lds, int wave, int lane, int lo, int hi, int wi, int nw) {
    unsigned char* ws = a.ws; LAS float* scr = (LAS float*)(lds + wave * 16384);
    for (int it = lo + wi; it < hi; it += nw) {
        int r = it;
        if (r < CV_I0) { const int kb = r / 352, nb = r % 352; transpose_item(a.in[I_WIN], DM, INC, (bf16*)(ws + WS_WIN), kb * 64, nb * 32, (size_t)nb * 32, scr, lane); continue; } r -= CV_I0;
        if (r < CV_I1) { const int kb = r / 64, nb = r % 64; transpose_item(a.in[I_WPA], HW, DM, (bf16*)(ws + WS_WPA), kb * 64, nb * 32, (size_t)nb * 32, scr, lane); continue; } r -= CV_I1;
        if (r < CV_I1) { const int kb = r / 64, nb = r % 64; transpose_item(a.in[I_WPB], HW, DM, (bf16*)(ws + WS_WPB), kb * 64, nb * 32, (size_t)nb * 32, scr, lane); continue; } r -= CV_I1;
        { const int kb = r / 64, nb = r % 64; transpose_item(a.in[I_WOUT], DM, DM, (bf16*)(ws + WS_WOUT), kb * 64, nb * 32, (size_t)nb * 32, scr, lane); }
    }
}
__device__ __forceinline__ bool late_convert(int G) { return ((NTOK / 256) * (INC / 256)) % G != 0; }
__device__ __forceinline__ void ada_chunk(const Args& a, LAS float* cond, LAS float* red, int tid, int chunk) {
    float* mod = (float*)(a.ws + WS_MOD);
    const int cg = tid & 15, rg = tid >> 4, col = chunk * 64 + cg * 4;
    f32x4 a0 = {0.f, 0.f, 0.f, 0.f}, a1 = {0.f, 0.f, 0.f, 0.f};
    const float* wp = a.in[I_WADA] + col;
#pragma unroll 8
    for (int d = rg; d < DM; d += 32) { const f32x4 w = *(const f32x4*)(wp + (size_t)d * 12288); a0 += w * cond[d]; a1 += w * cond[2048 + d]; }
    LAS float* rp = red + (rg * 16 + cg) * 8;
    rp[0] = a0[0]; rp[1] = a0[1]; rp[2] = a0[2]; rp[3] = a0[3]; rp[4] = a1[0]; rp[5] = a1[1]; rp[6] = a1[2]; rp[7] = a1[3];
    __syncthreads();
    if (tid < 128) { const int cg2 = tid >> 3, v = tid & 7; float s = 0.f;
        for (int r = 0; r < 32; ++r) s += red[(r * 16 + cg2) * 8 + v];
        const int b = v >> 2, colo = chunk * 64 + cg2 * 4 + (v & 3);
        __hip_atomic_store((unsigned*)&mod[b * 12288 + colo], __float_as_uint(s + a.in[I_BADA][colo]), __ATOMIC_RELAXED, __HIP_MEMORY_SCOPE_AGENT); }
    asm volatile("s_waitcnt vmcnt(0)" ::: "memory");
    __syncthreads();
    if (tid == 0) __hip_atomic_fetch_add((unsigned*)(a.ws + WS_CTL) + CW_MODC, 1u, __ATOMIC_RELAXED, __HIP_MEMORY_SCOPE_AGENT);
}
__device__ __forceinline__ int ada_early_chunks(int G) { return late_convert(G) && G == 256 ? 64 : 192; }
__device__ __forceinline__ void ph_prologue(const Args& a, const Ctx& X) {
    unsigned char* ws = a.ws;
    LAS float* cond = (LAS float*)X.lds;
    LAS float* red = (LAS float*)(X.lds + 16384);
    for (int i = X.tid; i < 4096; i += NTHR) { const float c = a.in[I_C][i]; cond[i] = c / (1.f + expf(-c)); }
    __syncthreads();
    for (int chunk = X.bid; chunk < ada_early_chunks(X.G); chunk += X.G) ada_chunk(a, cond, red, X.tid, chunk);
    if (X.bid == (X.G > 200 ? 200 : 0)) {
        float* LB = (float*)(ws + WS_LB);
        for (int i = X.tid; i < 2048; i += NTHR) { const float l0 = a.in[I_HGLB][i], l1 = a.in[I_HGLB][2048 + i]; LB[i] = 1.f / (1.f + expf(l1 - l0)); }
    }
    __syncthreads();
    {
        bf16* WG = (bf16*)(ws + WS_WG);
        for (int p = X.bid * NTHR + X.tid; p < 65536; p += X.G * NTHR) { const int lane = p & 63, ks = (p >> 6) & 3, q = (p >> 8) & 3, w = (p >> 10) & 7, h = p >> 13, g = lane >> 4, i = lane & 15;
            const float* sw = a.in[(q & 1) ? I_RGWX : I_RGWA] + ((size_t)((q >> 1) * 8 + h) * 128 + 32 * ks + 8 * g) * 128 + 16 * w + i;
            u32x4 o; o.x = pk2(sw[0], sw[128]); o.y = pk2(sw[256], sw[384]); o.z = pk2(sw[512], sw[640]); o.w = pk2(sw[768], sw[896]); *(u32x4*)(WG + (size_t)p * 8) = o; }
    }
    convert_items(a, X.lds, X.wave, X.lane, 0, late_convert(X.G) ? CV_I0 : CV_ALL, X.gw, X.NGW);
}

__device__ __forceinline__ float row_load_ss(const float* xrow, int lane, f32x4 (&v)[8]) {
    float s = 0.f;
#pragma unroll
    for (int j = 0; j < 8; ++j) { v[j] = *(const f32x4*)(xrow + 4 * lane + 256 * j); s += (v[j][0] * v[j][0] + v[j][1] * v[j][1]) + (v[j][2] * v[j][2] + v[j][3] * v[j][3]); }
    return wave_sum(s);
}
__device__ __forceinline__ void row_modulate(f32x4 (&v)[8], float rstd, const float* gain, const float* shift, const float* scale, int lane) {
#pragma unroll
    for (int j = 0; j < 8; ++j) { const int d = 4 * lane + 256 * j; const f32x4 g = *(const f32x4*)(gain + d), sh = *(const f32x4*)(shift + d), sc = *(const f32x4*)(scale + d);
        v[j] = v[j] * rstd * g * (sc + 1.f) + sh; }
}
__device__ __forceinline__ void ph_norm1(const Args& a, const Ctx& X) {
    const float* mod = (const float*)(a.ws + WS_MOD); bf16* H = (bf16*)(a.ws + WS_H);
    for (int row = X.gw; row < NTOK; row += X.NGW) {
        f32x4 v[8]; const float ss = row_load_ss(a.in[I_X] + (size_t)row * DM, X.lane, v);
        const float rstd = rsqrtf(ss * (1.f / DM) + EPS); const float* mb = mod + (row >> 12) * 12288;
        row_modulate(v, rstd, a.in[I_NORM1], mb, mb + DM, X.lane);
#pragma unroll
        for (int j = 0; j < 8; ++j) { u32x2 w; w.x = pk2(v[j][0], v[j][1]); w.y = pk2(v[j][2], v[j][3]); *(u32x2*)(H + (size_t)row * DM + 4 * X.lane + 256 * j) = w; }
    }
}


typedef short s16x4 __attribute__((ext_vector_type(4)));
#define MFMA16(a, b, c) __builtin_amdgcn_mfma_f32_16x16x32_bf16((a), (b), (c), 0, 0, 0)
__device__ __forceinline__ pg8::bf16x8 tr_frag(unsigned addr0, int RS, int lane) {
    const unsigned a0 = addr0 + (unsigned)((8 * (lane >> 4) + ((lane & 15) >> 2)) * RS + 8 * (lane & 3)), a1 = a0 + 4u * (unsigned)RS;
    s16x4 lo, hi;
    asm volatile("ds_read_b64_tr_b16 %0, %2\n\tds_read_b64_tr_b16 %1, %3\n\ts_waitcnt lgkmcnt(0)" : "=&v"(lo), "=&v"(hi) : "v"(a0), "v"(a1) : "memory");
    return __builtin_shufflevector(lo, hi, 0, 1, 2, 3, 4, 5, 6, 7);
}
__device__ __forceinline__ void tr_frag4(unsigned b0, unsigned b1, unsigned b2, unsigned b3, int RS, int lane, pg8::bf16x8 (&out)[4]) {
    const unsigned off = (unsigned)((8 * (lane >> 4) + ((lane & 15) >> 2)) * RS + 8 * (lane & 3)), r4 = 4u * (unsigned)RS;
    const unsigned a0 = b0 + off, a1 = b1 + off, a2 = b2 + off, a3 = b3 + off;
    s16x4 l0, h0, l1, h1, l2, h2, l3, h3;
    asm volatile("ds_read_b64_tr_b16 %0, %1" : "=v"(l0) : "v"(a0) : "memory"); asm volatile("ds_read_b64_tr_b16 %0, %1" : "=v"(h0) : "v"(a0 + r4) : "memory");
    asm volatile("ds_read_b64_tr_b16 %0, %1" : "=v"(l1) : "v"(a1) : "memory"); asm volatile("ds_read_b64_tr_b16 %0, %1" : "=v"(h1) : "v"(a1 + r4) : "memory");
    asm volatile("ds_read_b64_tr_b16 %0, %1" : "=v"(l2) : "v"(a2) : "memory"); asm volatile("ds_read_b64_tr_b16 %0, %1" : "=v"(h2) : "v"(a2 + r4) : "memory");
    asm volatile("ds_read_b64_tr_b16 %0, %1" : "=v"(l3) : "v"(a3) : "memory"); asm volatile("ds_read_b64_tr_b16 %0, %1" : "=v"(h3) : "v"(a3 + r4) : "memory");
    asm volatile("s_waitcnt lgkmcnt(0)" : "+v"(l0), "+v"(h0), "+v"(l1), "+v"(h1), "+v"(l2), "+v"(h2), "+v"(l3), "+v"(h3) :: "memory");
    out[0] = __builtin_shufflevector(l0, h0, 0, 1, 2, 3, 4, 5, 6, 7); out[1] = __builtin_shufflevector(l1, h1, 0, 1, 2, 3, 4, 5, 6, 7);
    out[2] = __builtin_shufflevector(l2, h2, 0, 1, 2, 3, 4, 5, 6, 7); out[3] = __builtin_shufflevector(l3, h3, 0, 1, 2, 3, 4, 5, 6, 7);
}
constexpr int HRS = 272, PRS = 144;
constexpr int HL_VS = 0, HL_QD = 17408, HL_KH2 = 34816, HL_QT2 = 52224, HL_KH1 = 60928, HL_PS = 69632, HL_TOT = 78848, HL_BND = 80896, HL_PART = 81408;
__device__ __forceinline__ void lds_st_bf16(LAS unsigned char* p, float v) { *(LAS unsigned short*)p = (unsigned short)(pk2(v, 0.f) & 0xffffu); }
__device__ __forceinline__ void hg_load_v(const bf16* V, int row_base, int col_base, LAS unsigned char* lds, int tid) {
#pragma unroll
    for (int i = 0; i < 2; ++i) { const int ch = tid + NTHR * i, r = ch >> 4, c = ch & 15;
        *(LAS u32x4*)(lds + HL_VS + r * HRS + c * 16) = *(const u32x4*)(V + (size_t)(row_base + r) * HW + col_base + c * 8); }
}
__device__ __forceinline__ void ph_hg_local(const Args& a, const Ctx& X) {
    const bf16* V = (const bf16*)(a.ws + WS_V); bf16* SB = (bf16*)(a.ws + WS_SA); float* DEC = (float*)(a.ws + WS_SU);
    LAS unsigned char* lds = X.lds; LAS float* TOT = (LAS float*)(lds + HL_TOT);
    const int k = X.tid & 127, ts = X.tid >> 7, fr = X.lane & 15, fq = X.lane >> 4;
    for (int u = X.bid; u < 2048; u += X.G) {
        const int c = u & 63, h = (u >> 6) & 7, b = (u >> 9) & 1, dir = u >> 10, row_base = b * SEQ + c * 64, col_base = h * 128;
        const float* Gp = (const float*)(a.ws + (dir ? WS_GB : WS_GF)) + (size_t)row_base * HW + col_base + k;
        hg_load_v(V, row_base, col_base, lds, X.tid);
        float g[16], cs[16]; float s = 0.f;
#pragma unroll
        for (int i = 0; i < 16; ++i) { const int r = dir ? 63 - (16 * ts + i) : 16 * ts + i; g[i] = Gp[(size_t)r * HW]; }
#pragma unroll
        for (int i = 0; i < 16; ++i) { s += g[i]; cs[i] = s; }
        TOT[ts * 128 + k] = s;
        __syncthreads();
        const float t0 = TOT[k], t1 = TOT[128 + k], t2 = TOT[256 + k], t3 = TOT[384 + k], tot = (t0 + t1) + (t2 + t3);
        const float off = ts == 0 ? 0.f : ts == 1 ? t0 : ts == 2 ? t0 + t1 : (t0 + t1) + t2;
#pragma unroll
        for (int i = 0; i < 16; ++i) { const int r = dir ? 63 - (16 * ts + i) : 16 * ts + i;
            const float kd = (1.f - __expf(g[i])) * __expf(tot - (off + cs[i]));
            lds_st_bf16(lds + HL_QD + r * HRS + k * 2, kd); }
        if (ts == 0) DEC[(size_t)u * 128 + k] = __expf(tot);
        __syncthreads();
        f32x4 acc[8];
#pragma unroll
        for (int j = 0; j < 8; ++j) acc[j] = (f32x4){0.f, 0.f, 0.f, 0.f};
        const int kb = X.wave;
#pragma unroll
        for (int rs = 0; rs < 2; ++rs) { const pg8::bf16x8 af = tr_frag((unsigned)(HL_QD + 32 * rs * HRS + 16 * kb * 2), HRS, X.lane);
            pg8::bf16x8 bv[2][4]; const unsigned vb0 = (unsigned)(HL_VS + 32 * rs * HRS);
            tr_frag4(vb0, vb0 + 32, vb0 + 64, vb0 + 96, HRS, X.lane, bv[0]); tr_frag4(vb0 + 128, vb0 + 160, vb0 + 192, vb0 + 224, HRS, X.lane, bv[1]);
#pragma unroll
            for (int j = 0; j < 8; ++j) acc[j] = MFMA16(af, bv[j >> 2][j & 3], acc[j]); }
        bf16* so = SB + (size_t)u * 16384;
#pragma unroll
        for (int j = 0; j < 8; ++j) { u32x2 w; w.x = pk2(acc[j][0], acc[j][1]); w.y = pk2(acc[j][2], acc[j][3]);
            *(u32x2*)(so + (((kb >> 1) * 8 + j) * 64 + (2 * (kb & 1) + (fq >> 1)) * 16 + fr) * 8 + 4 * (fq & 1)) = w; }
        __syncthreads();
    }
}
__device__ __forceinline__ void ph_hg_scan(const Args& a, const Ctx& X) {
    bf16* SB = (bf16*)(a.ws + WS_SA); const float* DEC = (const float*)(a.ws + WS_SU);
    if (X.tid < 256)
        for (int gid = X.bid * 256 + X.tid; gid < 65536; gid += X.G * 256) {
            const int seq = gid >> 11, e8 = gid & 2047, dir = seq >> 4, k0 = 32 * (e8 >> 9) + 8 * ((e8 & 63) >> 4);
            float s[8];
#pragma unroll
            for (int j = 0; j < 8; ++j) s[j] = 0.f;
#pragma unroll 4
            for (int cc = 0; cc < 64; ++cc) { const int c = dir ? 63 - cc : cc; const size_t un = (size_t)seq * 64 + c;
                u32x4* p = (u32x4*)(SB + un * 16384 + (size_t)e8 * 8); const u32x4 loc = *p;
                const f32x4 d0 = *(const f32x4*)(DEC + un * 128 + k0), d1 = *(const f32x4*)(DEC + un * 128 + k0 + 4);
                u32x4 o; o.x = pk2(s[0], s[1]); o.y = pk2(s[2], s[3]); o.z = pk2(s[4], s[5]); o.w = pk2(s[6], s[7]); *p = o;
                s[0] = d0[0] * s[0] + bflo(loc.x); s[1] = d0[1] * s[1] + bfhi(loc.x); s[2] = d0[2] * s[2] + bflo(loc.y); s[3] = d0[3] * s[3] + bfhi(loc.y);
                s[4] = d1[0] * s[4] + bflo(loc.z); s[5] = d1[1] * s[5] + bfhi(loc.z); s[6] = d1[2] * s[6] + bflo(loc.w); s[7] = d1[3] * s[7] + bfhi(loc.w); }
        }
}
__device__ __forceinline__ void ph_hg_out(const Args& a, const Ctx& X) {
    const bf16* Q = (const bf16*)(a.ws + WS_Q); const bf16* V = (const bf16*)(a.ws + WS_V); const bf16* SB = (const bf16*)(a.ws + WS_SA);
    const bf16* GO = (const bf16*)(a.ws + WS_GOUT); bf16* HGO = (bf16*)(a.ws + WS_HGO);
    LAS unsigned char* lds = X.lds; LAS float* TOT = (LAS float*)(lds + HL_TOT); LAS float* BND = (LAS float*)(lds + HL_BND); LAS float* PART = (LAS float*)(lds + HL_PART);
    const int k = X.tid & 127, ts = X.tid >> 7, fr = X.lane & 15, fq = X.lane >> 4, rb = X.wave & 3, dvh = X.wave >> 2;
    for (int u = X.bid; u < 1024; u += X.G) {
        const int c = u & 63, h = (u >> 6) & 7, b = u >> 9, row_base = b * SEQ + c * 64, col_base = h * 128;
        hg_load_v(V, row_base, col_base, lds, X.tid);
        f32x4 O[4];
#pragma unroll
        for (int j = 0; j < 4; ++j) O[j] = (f32x4){0.f, 0.f, 0.f, 0.f};
        for (int dir = 0; dir < 2; ++dir) {
            const float* Gp = (const float*)(a.ws + (dir ? WS_GB : WS_GF)) + (size_t)row_base * HW + col_base + k;
            const bf16* Qp = Q + (size_t)row_base * HW + col_base + k;
            float g[16], cs[16], qv[16]; float s = 0.f;
#pragma unroll
            for (int i = 0; i < 16; ++i) { const int r = dir ? 63 - (16 * ts + i) : 16 * ts + i; g[i] = Gp[(size_t)r * HW]; qv[i] = bf2f(Qp[(size_t)r * HW]); }
#pragma unroll
            for (int i = 0; i < 16; ++i) { s += g[i]; cs[i] = s; }
            TOT[ts * 128 + k] = s;
            __syncthreads();
            const float t0 = TOT[k], t1 = TOT[128 + k], t2 = TOT[256 + k];
            const float off = ts == 0 ? 0.f : ts == 1 ? t0 : ts == 2 ? t0 + t1 : (t0 + t1) + t2, bnd = t0 + t1;
            const int sec_row0 = dir ? 0 : 32, first_row0 = dir ? 32 : 0;
#pragma unroll
            for (int i = 0; i < 16; ++i) { const int r = dir ? 63 - (16 * ts + i) : 16 * ts + i; const float C = off + cs[i], kk = 1.f - __expf(g[i]);
                lds_st_bf16(lds + HL_QD + r * HRS + k * 2, qv[i] * __expf(C));
                lds_st_bf16(lds + HL_KH2 + r * HRS + k * 2, kk * __expf(fminf(bnd - C, 80.f)));
                if (ts >= 2) lds_st_bf16(lds + HL_QT2 + (r - sec_row0) * HRS + k * 2, qv[i] * __expf(C - bnd));
                else         lds_st_bf16(lds + HL_KH1 + (r - first_row0) * HRS + k * 2, kk * __expf(fminf(-C, 80.f))); }
            __syncthreads();
            const bf16* sp = SB + ((size_t)((dir * 2 + b) * 8 + h) * 64 + c) * 16384;
            pg8::bf16x8 Sf[4][4];
#pragma unroll
            for (int ks = 0; ks < 4; ++ks)
#pragma unroll
                for (int j = 0; j < 4; ++j) Sf[ks][j] = *(const pg8::bf16x8*)(sp + ((ks * 8 + 4 * dvh + j) * 64 + X.lane) * 8);
#pragma unroll
            for (int ub = 0; ub < 2; ++ub) { const int blk = 2 * X.wave + ub, tb = blk >> 2, sb = blk & 3;
                const bool allowed = dir ? (sb >= tb) : (sb <= tb), tfirst = dir ? (tb >= 2) : (tb < 2);
                f32x4 p = {0.f, 0.f, 0.f, 0.f};
                if (allowed) {
                    const int qoff = tfirst ? HL_QD + (16 * tb + fr) * HRS : HL_QT2 + (16 * tb - sec_row0 + fr) * HRS;
                    const int koff = tfirst ? HL_KH1 + (16 * sb - first_row0 + fr) * HRS : HL_KH2 + (16 * sb + fr) * HRS;
#pragma unroll
                    for (int ks = 0; ks < 4; ++ks) { const pg8::bf16x8 qf = *(const LAS pg8::bf16x8*)(lds + qoff + ks * 64 + fq * 16), kf = *(const LAS pg8::bf16x8*)(lds + koff + ks * 64 + fq * 16);
                        p = MFMA16(kf, qf, p); }
                    if (tb == sb) {
#pragma unroll
                        for (int j = 0; j < 4; ++j) { const bool keep = dir ? (4 * fq + j >= fr) : (4 * fq + j <= fr); p[j] = keep ? p[j] : 0.f; } }
                }
                u32x2 w; w.x = pk2(p[0], p[1]); w.y = pk2(p[2], p[3]);
                *(LAS u32x2*)(lds + HL_PS + (16 * tb + fr) * PRS + (16 * sb + 4 * fq) * 2) = w; }
            __syncthreads();
#pragma unroll
            for (int ks = 0; ks < 2; ++ks) { const pg8::bf16x8 pf = *(const LAS pg8::bf16x8*)(lds + HL_PS + (16 * rb + fr) * PRS + ks * 64 + fq * 16);
                { pg8::bf16x8 vf[4]; const unsigned vb0 = (unsigned)(HL_VS + 32 * ks * HRS + 128 * dvh); tr_frag4(vb0, vb0 + 32, vb0 + 64, vb0 + 96, HRS, X.lane, vf);
#pragma unroll
                for (int j = 0; j < 4; ++j) O[j] = MFMA16(vf[j], pf, O[j]); } }
#pragma unroll
            for (int ks = 0; ks < 4; ++ks) { const pg8::bf16x8 qf = *(const LAS pg8::bf16x8*)(lds + HL_QD + (16 * rb + fr) * HRS + ks * 64 + fq * 16);
#pragma unroll
                for (int j = 0; j < 4; ++j) O[j] = MFMA16(Sf[ks][j], qf, O[j]); }
            __syncthreads();
        }
        float ss = 0.f;
#pragma unroll
        for (int j = 0; j < 4; ++j) ss += (O[j][0] * O[j][0] + O[j][1] * O[j][1]) + (O[j][2] * O[j][2] + O[j][3] * O[j][3]);
        ss += __shfl_xor(ss, 16); ss += __shfl_xor(ss, 32);
        if (fq == 0) PART[dvh * 64 + 16 * rb + fr] = ss;
        __syncthreads();
        const float rstd = rsqrtf((PART[16 * rb + fr] + PART[64 + 16 * rb + fr]) * (1.f / 128.f) + EPS);
        const size_t ro = (size_t)(row_base + 16 * rb + fr) * HW + col_base;
#pragma unroll
        for (int j = 0; j < 4; ++j) { const int dv = 16 * (4 * dvh + j) + 4 * fq; const f32x4 nm = *(const f32x4*)(a.in[I_HGNORM] + col_base + dv); const u32x2 gg = *(const u32x2*)(GO + ro + dv);
            const f32x4 t = O[j] * rstd * nm; u32x2 w; w.x = pk2(t[0] * bflo(gg.x), t[1] * bfhi(gg.x)); w.y = pk2(t[2] * bflo(gg.y), t[3] * bfhi(gg.y));
            *(u32x2*)(HGO + ro + dv) = w; }
        __syncthreads();
    }
}

constexpr int RL_XC = 0, RL_XF = 17408, XFS = 132;
template <bool REV> __device__ __forceinline__ void rg_chunk_scan(const float (&av)[4][4], const float (&uv)[4][4], float (&hh)[4][4], float (&pp)[4][4], float& Aend, float& Eend, int lane) {
    const int fq = lane >> 4; float As[4], Hs[4];
#pragma unroll
    for (int rb = 0; rb < 4; ++rb) { float h = 0.f, p = 1.f;
#pragma unroll
        for (int ri = 0; ri < 4; ++ri) { const int reg = REV ? 3 - ri : ri; h = av[rb][reg] * h + uv[rb][reg]; p *= av[rb][reg]; hh[rb][reg] = h; pp[rb][reg] = p; }
        As[rb] = p; Hs[rb] = h; }
    const int n1 = REV ? lane + 16 : lane - 16, n2 = REV ? lane + 32 : lane - 32;
    const bool ok1 = REV ? (fq <= 2) : (fq >= 1), ok2 = REV ? (fq <= 1) : (fq >= 2);
    float cA = 1.f, cH = 0.f;
#pragma unroll
    for (int rbi = 0; rbi < 4; ++rbi) { const int rb = REV ? 3 - rbi : rbi; float A1 = As[rb], H1 = Hs[rb];
        { const float Ap = __shfl(A1, n1 & 63), Hp = __shfl(H1, n1 & 63); if (ok1) { H1 = A1 * Hp + H1; A1 = Ap * A1; } }
        { const float Ap = __shfl(A1, n2 & 63), Hp = __shfl(H1, n2 & 63); if (ok2) { H1 = A1 * Hp + H1; A1 = Ap * A1; } }
        float Ae = __shfl(A1, n1 & 63), He = __shfl(H1, n1 & 63); if (!ok1) { Ae = 1.f; He = 0.f; }
        const int tl = (REV ? 0 : 48) + (lane & 15); const float At = __shfl(A1, tl), Ht = __shfl(H1, tl);
        const float Hin = Ae * cH + He, Ain = cA * Ae;
#pragma unroll
        for (int reg = 0; reg < 4; ++reg) { hh[rb][reg] += pp[rb][reg] * Hin; pp[rb][reg] *= Ain; }
        cH = At * cH + Ht; cA = cA * At; }
    Aend = cA; Eend = cH;
}
__device__ __forceinline__ void ph_rg_local(const Args& a, const Ctx& X) {
    const bf16* RGX = (const bf16*)(a.ws + WS_RGX); const bf16* WG = (const bf16*)(a.ws + WS_WG);
    float* HL = (float*)(a.ws + WS_HL); unsigned* PP = (unsigned*)(a.ws + WS_PP); float2* AE = (float2*)(a.ws + WS_AE);
    LAS unsigned char* lds = X.lds; LAS float* XF = (LAS float*)(lds + RL_XF);
    const int w = X.wave, fr = X.lane & 15, fq = X.lane >> 4;
    for (int u = X.bid; u < 1024; u += X.G) {
        const int h = u & 7, c = (u >> 3) & 63, b = u >> 9, row_base = b * SEQ + c * 64, col_base = h * 128;
        pg8::bf16x8 Wf[4][4];
#pragma unroll
        for (int q = 0; q < 4; ++q)
#pragma unroll
            for (int ks = 0; ks < 4; ++ks) Wf[q][ks] = *(const pg8::bf16x8*)(WG + ((size_t)((h * 8 + w) * 16 + q * 4 + ks) * 64 + X.lane) * 8);
#pragma unroll
        for (int it = 0; it < 2; ++it) { const int item = X.tid + NTHR * it, r = item >> 4, c8 = item & 15, ch0 = col_base + c8 * 8;
            f32x4 s0 = *(const f32x4*)(a.in[I_CONVB] + ch0), s1 = *(const f32x4*)(a.in[I_CONVB] + ch0 + 4);
#pragma unroll
            for (int j = 0; j < 4; ++j) { const int s = c * 64 + r - 2 + j;
                if (s >= 0 && s < SEQ) { const u32x4 xv = *(const u32x4*)(RGX + (size_t)(b * SEQ + s) * HW + ch0);
                    const f32x4 w0 = *(const f32x4*)(a.in[I_CONVW] + j * 1024 + ch0), w1 = *(const f32x4*)(a.in[I_CONVW] + j * 1024 + ch0 + 4);
                    s0[0] += w0[0] * bflo(xv.x); s0[1] += w0[1] * bfhi(xv.x); s0[2] += w0[2] * bflo(xv.y); s0[3] += w0[3] * bfhi(xv.y);
                    s1[0] += w1[0] * bflo(xv.z); s1[1] += w1[1] * bfhi(xv.z); s1[2] += w1[2] * bflo(xv.w); s1[3] += w1[3] * bfhi(xv.w); } }
            u32x4 pk; pk.x = pk2(s0[0], s0[1]); pk.y = pk2(s0[2], s0[3]); pk.z = pk2(s1[0], s1[1]); pk.w = pk2(s1[2], s1[3]);
            *(LAS u32x4*)(lds + RL_XC + r * HRS + c8 * 16) = pk;
            *(LAS f32x4*)(XF + r * XFS + c8 * 8) = s0; *(LAS f32x4*)(XF + r * XFS + c8 * 8 + 4) = s1; }
        __syncthreads();
        f32x4 acc[4][4];
#pragma unroll
        for (int q = 0; q < 4; ++q)
#pragma unroll
            for (int rb = 0; rb < 4; ++rb) acc[q][rb] = (f32x4){0.f, 0.f, 0.f, 0.f};
#pragma unroll
        for (int rb = 0; rb < 4; ++rb) { pg8::bf16x8 af[4];
#pragma unroll
            for (int ks = 0; ks < 4; ++ks) af[ks] = *(const LAS pg8::bf16x8*)(lds + RL_XC + (16 * rb + fr) * HRS + ks * 64 + fq * 16);
#pragma unroll
            for (int q = 0; q < 4; ++q)
#pragma unroll
                for (int ks = 0; ks < 4; ++ks) acc[q][rb] = MFMA16(af[ks], Wf[q][ks], acc[q][rb]); }
        const int ch = col_base + 16 * w + fr;
        float xc[4][4];
#pragma unroll
        for (int rb = 0; rb < 4; ++rb)
#pragma unroll
            for (int reg = 0; reg < 4; ++reg) xc[rb][reg] = XF[(16 * rb + 4 * fq + reg) * XFS + 16 * w + fr];
        float hsum[4][4]; unsigned ppk[4][4];
#pragma unroll
        for (int dir = 0; dir < 2; ++dir) {
            const float ba = a.in[I_RGBA][dir * 1024 + ch], bx = a.in[I_RGBX][dir * 1024 + ch], sp = log1pf(expf(-a.in[I_LAM][dir * 1024 + ch]));
            float av[4][4], uv[4][4], hh[4][4], pp[4][4];
#pragma unroll
            for (int rb = 0; rb < 4; ++rb)
#pragma unroll
                for (int reg = 0; reg < 4; ++reg) { const float rr = fsigmoid(acc[2 * dir][rb][reg] + ba), gi = fsigmoid(acc[2 * dir + 1][rb][reg] + bx);
                    const float la = -8.f * rr * sp, y2 = 2.f * la; av[rb][reg] = __expf(la);
                    const float om = y2 > -0.02f ? -y2 * (1.f + y2 * (0.5f + y2 * (1.f / 6.f))) : 1.f - __expf(y2);
                    uv[rb][reg] = __builtin_amdgcn_sqrtf(om) * (gi * xc[rb][reg]); }
            float Aend, Eend;
            if (dir == 0) rg_chunk_scan<false>(av, uv, hh, pp, Aend, Eend, X.lane); else rg_chunk_scan<true>(av, uv, hh, pp, Aend, Eend, X.lane);
            if (fq == 0) AE[((size_t)dir * 128 + b * 64 + c) * 1024 + ch] = make_float2(Aend, Eend);
#pragma unroll
            for (int rb = 0; rb < 4; ++rb)
#pragma unroll
                for (int reg = 0; reg < 4; ++reg) { if (dir == 0) { hsum[rb][reg] = hh[rb][reg]; ppk[rb][reg] = pk2(pp[rb][reg], 0.f) & 0xffffu; }
                    else { hsum[rb][reg] += hh[rb][reg]; ppk[rb][reg] |= pk2(0.f, pp[rb][reg]); } }
        }
#pragma unroll
        for (int rb = 0; rb < 4; ++rb)
#pragma unroll
            for (int reg = 0; reg < 4; ++reg) { const size_t o = (size_t)(row_base + 16 * rb + 4 * fq + reg) * HW + ch; HL[o] = hsum[rb][reg]; PP[o] = ppk[rb][reg]; }
        __syncthreads();
    }
}
__device__ __forceinline__ void ph_rg_carry(const Args& a, const Ctx& X) {
    const float2* AE = (const float2*)(a.ws + WS_AE); float* CIN = (float*)(a.ws + WS_CIN);
    if (X.tid >= 256 && X.tid < 272)
        for (int gid = X.bid * 16 + X.tid - 256; gid < 4096; gid += X.G * 16) {
            const int dir = gid >> 11, b = (gid >> 10) & 1, ch = gid & 1023; float cin = 0.f;
#pragma unroll 8
            for (int cc = 0; cc < 64; ++cc) { const int c = dir ? 63 - cc : cc; const size_t o = ((size_t)dir * 128 + b * 64 + c) * 1024 + ch; const float2 ae = AE[o]; CIN[o] = cin; cin = ae.x * cin + ae.y; }
        }
}
__device__ __forceinline__ void ph_rg_out(const Args& a, const Ctx& X) {
    const float* HL = (const float*)(a.ws + WS_HL); const unsigned* PP = (const unsigned*)(a.ws + WS_PP); const float* CIN = (const float*)(a.ws + WS_CIN);
    const bf16* RGY = (const bf16*)(a.ws + WS_RGY); bf16* RGO = (bf16*)(a.ws + WS_RGO);
    for (size_t i = ((size_t)X.bid * NTHR + X.tid) * 4; i < (size_t)NTOK * HW; i += (size_t)X.G * NTHR * 4) {
        const size_t row = i >> 10; const int ch = (int)(i & 1023); const size_t co = (row >> 6) * 1024 + ch;
        const f32x4 hl = *(const f32x4*)(HL + i), cf = *(const f32x4*)(CIN + co), cb = *(const f32x4*)(CIN + (size_t)128 * 1024 + co); const u32x4 pp = *(const u32x4*)(PP + i); const u32x2 y = *(const u32x2*)(RGY + i);
        const float o0 = (hl[0] + bflo(pp.x) * cf[0] + bfhi(pp.x) * cb[0]) * bflo(y.x), o1 = (hl[1] + bflo(pp.y) * cf[1] + bfhi(pp.y) * cb[1]) * bfhi(y.x);
        const float o2 = (hl[2] + bflo(pp.z) * cf[2] + bfhi(pp.z) * cb[2]) * bflo(y.y), o3 = (hl[3] + bflo(pp.w) * cf[3] + bfhi(pp.w) * cb[3]) * bfhi(y.y);
        u32x2 w; w.x = pk2(o0, o1); w.y = pk2(o2, o3); *(u32x2*)(RGO + i) = w; }
}

template <int MODE>
__device__ __forceinline__ void moe_gemm(const Args& a, const Ctx& X, const int nu, const long Lstart, const int base) {
    constexpr int K = MODE == 1 ? DM : DEX, NT = K / 64, ABUF = 0  , BBUF = 65536  ;
    LAS unsigned char* lds = X.lds;
    constexpr int ldb = MODE == 1 ? DEX : DM;
    const int2* tab = (const int2*)(a.ws + WS_UTAB); const int* rowtok = (const int*)(a.ws + WS_RTOK);
    unsigned* hcnt = (unsigned*)(a.ws + WS_CTL) + CW_HID;
    const int nuX = __builtin_amdgcn_readfirstlane(nu >> 3), rank = __builtin_amdgcn_readfirstlane(X.vb >> 3), xq = __builtin_amdgcn_readfirstlane(X.vb & 7), r3 = nuX & 31, al = 32 - r3; const bool dealt = MODE == 2 && X.G == 256;
    for (int it = 0; ; ++it) {
        int ti;
        if (!dealt) { const int L = (int)Lstart + it * X.G; if (L >= base + nu) break; ti = L - base; }
        else { const int j = rank >= r3 ? (it < 2 ? (rank - r3) + al * it : 2 * al + rank + 32 * (it - 2)) : 2 * al + rank + 32 * it; if (j >= nuX) break; ti = 8 * j + xq; }
        const int2 tt = tab[ti]; const int pm = __builtin_amdgcn_readfirstlane(tt.x), e = __builtin_amdgcn_readfirstlane(tt.y >> 3), pnl = __builtin_amdgcn_readfirstlane(tt.y & 7);
        if (MODE == 2) {
            if (X.wave == 0) { unsigned sp = 0;
                while ((unsigned)__builtin_amdgcn_readfirstlane((int)__hip_atomic_load(hcnt + pm, __ATOMIC_RELAXED, __HIP_MEMORY_SCOPE_AGENT)) < 64u) { __builtin_amdgcn_s_sleep(2); if (++sp > (1u << 22)) break; }
                __builtin_amdgcn_fence(__ATOMIC_ACQUIRE, "agent"); asm volatile("s_waitcnt vmcnt(0)" ::: "memory"); }
            __syncthreads(); }
        unsigned z0 = 0u; asm volatile("" : "+v"(z0)); const int ln = (int)__builtin_amdgcn_mbcnt_hi(~0u, __builtin_amdgcn_mbcnt_lo(~0u, z0));
        int aoff, boff, aR0, aC0, bbase; unsigned bofs;
        { const int tid = X.wave * 64 + ln, wm = X.wave >> 2, wn = X.wave & 3, fr = ln & 15, fq = ln >> 4;
          aoff = pg8::lds_byte(wm * 128 + fr, fq * 8); boff = (wn * 4) * 2048 + fr * 64 + ((fq ^ ((fr >> 2) & 3)) * 16);
          pg8::stage_rc(tid * 16, aR0, aC0);
          int kgq, n0;
          if (MODE == 1) { const int mcol = 4 * (ln & 31); kgq = 2 * (X.wave >> 1) + (ln >> 5); n0 = 64 * (mcol >> 5) + 32 * (X.wave & 1) + (mcol & 31); bofs = (unsigned)((8 * kgq) * DEX + mcol) * 4u; }
          else { kgq = X.wave; n0 = 4 * ln; bofs = (unsigned)((8 * kgq) * DM + n0) * 4u; }
          bbase = ((n0 >> 4) * 2 + (kgq >> 2)) * 1024 + (n0 & 15) * 64 + (((kgq & 3) ^ ((n0 >> 2) & 3)) * 16); }
        const unsigned char* abase = MODE == 1 ? a.ws + WS_H : a.ws + WS_HID;
        unsigned aofs[4];
#pragma unroll
        for (int i = 0; i < 4; ++i) { const int r = pm * 256 + aR0 + 64 * i;
            aofs[i] = MODE == 1 ? (unsigned)rowtok[r] * (DM * 2) + aC0 * 2 : (unsigned)r * (DEX * 2) + aC0 * 2; }
        const unsigned char* bsrc = MODE == 1 ? (const unsigned char*)(a.in[(X.wave & 1) ? I_WUP : I_WGATE] + (size_t)e * DM * DEX + pnl * 128)
                                              : (const unsigned char*)(a.in[I_WDOWN] + (size_t)e * DEX * DM + pnl * 256);
        f32x4 acc[8][4];
#pragma unroll
        for (int m = 0; m < 8; ++m)
#pragma unroll
            for (int n = 0; n < 4; ++n) acc[m][n] = (f32x4){0.f, 0.f, 0.f, 0.f};
        f32x4 rb0[8];
        const __amdgpu_buffer_rsrc_t brsrc = __builtin_amdgcn_make_buffer_rsrc((void*)bsrc, 0, 0x7fffffff, 0x00020000);
        LAS unsigned char* const adst = lds + ABUF + X.wave * 1024;
        const __amdgpu_buffer_rsrc_t arsrc = __builtin_amdgcn_make_buffer_rsrc((void*)abase, 0, 0x7fffffff, 0x00020000);
#define MOE_DMA_A(t, buf) do { _Pragma("unroll") for (int i = 0; i < 4; ++i) \
        __builtin_amdgcn_raw_ptr_buffer_load_lds(arsrc, (LAS unsigned*)(adst + (buf) * 32768 + i * 8192), 16, (int)aofs[i], (t) * 128, 0, 0); } while (0)
#define MOE_LOAD(rb, t) do { _Pragma("unroll") for (int j = 0; j < 8; ++j) rb[j] = __builtin_bit_cast(f32x4, __builtin_amdgcn_raw_buffer_load_b128(brsrc, (int)bofs, ((t) * 64 + j) * ldb * 4, 0)); } while (0)
#define MOE_PK(rb, c) (u32x4){pk2(rb[0][c], rb[1][c]), pk2(rb[2][c], rb[3][c]), pk2(rb[4][c], rb[5][c]), pk2(rb[6][c], rb[7][c])}
#define MOE_STORE(rb, buf) do { const u32x4 p0 = MOE_PK(rb, 0), p1 = MOE_PK(rb, 1), p2 = MOE_PK(rb, 2), p3 = MOE_PK(rb, 3); LAS unsigned char* bw = lds + BBUF + (buf) * 32768 + bbase; \
        *(LAS u32x4*)(bw) = p0; *(LAS u32x4*)(bw + 64) = p1; *(LAS u32x4*)(bw + 128) = p2; *(LAS u32x4*)(bw + 192) = p3; } while (0)
#define MOE_FRAGB(bs, k, buf) do { _Pragma("unroll") for (int n = 0; n < 4; ++n) bs[n] = *(const LAS pg8::bf16x8*)(lds + BBUF + (buf) * 32768 + boff + n * 2048 + (k) * 1024); } while (0)
#define MOE_FRAGA(as, k, buf, m0) do { _Pragma("unroll") for (int m = 0; m < 2; ++m) as[m] = *(const LAS pg8::bf16x8*)(lds + ABUF + (buf) * 32768 + aoff + ((m0) + m) * 2048 + (k) * 1024); } while (0)
#define MOE_MMA(bs, as, m0) do { _Pragma("unroll") for (int m = 0; m < 2; ++m) _Pragma("unroll") for (int n = 0; n < 4; ++n) acc[(m0) + m][n] = MFMA16(bs[n], as[m], acc[(m0) + m][n]); } while (0)
#define MOE_SB() __builtin_amdgcn_sched_barrier(0)
#define MOE_BAR(nv) do { asm volatile("s_waitcnt vmcnt(" #nv ") lgkmcnt(0)" ::: "memory"); __builtin_amdgcn_s_barrier(); asm volatile("" ::: "memory"); } while (0)
#define MOE_STAGE(tt, bufc) do { if ((tt) + 1 < NT) MOE_STORE(rb0, (bufc) ^ 1); MOE_SB(); if ((tt) + 2 < NT) MOE_LOAD(rb0, (tt) + 2); MOE_SB(); } while (0)
#define MOE_STEP(tt, bufc) do { MOE_FRAGB(b0, 0, bufc); MOE_FRAGA(a0, 0, bufc, 0); MOE_SB(); \
        if ((tt) + 1 < NT) MOE_DMA_A((tt) + 1, (bufc) ^ 1); MOE_SB(); if (!late) MOE_STAGE(tt, bufc); MOE_SB(); \
        MOE_FRAGA(a1, 0, bufc, 2); MOE_MMA(b0, a0, 0); MOE_SB(); MOE_FRAGA(a0, 0, bufc, 4); MOE_MMA(b0, a1, 2); MOE_SB(); MOE_FRAGA(a1, 0, bufc, 6); MOE_MMA(b0, a0, 4); MOE_SB(); \
        MOE_FRAGB(b1, 1, bufc); MOE_FRAGA(a0, 1, bufc, 0); MOE_MMA(b0, a1, 6); MOE_SB(); \
        if (late) MOE_STAGE(tt, bufc); MOE_SB(); \
        MOE_FRAGA(a1, 1, bufc, 2); MOE_MMA(b1, a0, 0); MOE_SB(); MOE_FRAGA(a0, 1, bufc, 4); MOE_MMA(b1, a1, 2); MOE_SB(); MOE_FRAGA(a1, 1, bufc, 6); MOE_MMA(b1, a0, 4); MOE_SB(); \
        MOE_MMA(b1, a1, 6); MOE_SB(); \
        if ((tt) + 2 < NT) MOE_BAR(8); else MOE_BAR(0); } while (0)
        const bool late = X.wave >= 4;
        pg8::bf16x8 a0[2], a1[2], b0[4], b1[4];
        MOE_LOAD(rb0, 0); MOE_DMA_A(0, 0); MOE_STORE(rb0, 0); __builtin_amdgcn_sched_barrier(0); MOE_LOAD(rb0, 1); __builtin_amdgcn_sched_barrier(0);
        MOE_BAR(8);
        for (int t = 0; t < NT; t += 2) { MOE_STEP(t, 0); MOE_STEP(t + 1, 1); }
#undef MOE_DMA_A
#undef MOE_STAGE
#undef MOE_BAR
#undef MOE_FRAGA
#undef MOE_SB
#undef MOE_FRAGB
#undef MOE_MMA
#undef MOE_STEP
#undef MOE_LOAD
#undef MOE_PK
#undef MOE_STORE
        unsigned z1 = 0u; asm volatile("" : "+v"(z1)); const int l2 = (int)__builtin_amdgcn_mbcnt_hi(~0u, __builtin_amdgcn_mbcnt_lo(~0u, z1)); const int wm = X.wave >> 2, wn = X.wave & 3, fr = l2 & 15, fq = l2 >> 4;
        const size_t row0 = (size_t)pm * 256 + 128 * wm + fr;
        if (MODE == 1) { bf16* HID = (bf16*)(a.ws + WS_HID);
#pragma unroll
            for (int m = 0; m < 8; ++m)
#pragma unroll
                for (int nb = 0; nb < 2; ++nb) { const f32x4 g = acc[m][nb], up = acc[m][nb + 2];
                    u32x2 wv; wv.x = pk2(fsilu(g[0]) * up[0], fsilu(g[1]) * up[1]); wv.y = pk2(fsilu(g[2]) * up[2], fsilu(g[3]) * up[3]);
                    __hip_atomic_store((unsigned long long*)(HID + (row0 + 16 * m) * DEX + pnl * 128 + 32 * wn + 16 * nb + 4 * fq), ((unsigned long long)wv.y << 32) | wv.x, __ATOMIC_RELAXED, __HIP_MEMORY_SCOPE_AGENT); }
            asm volatile("s_waitcnt vmcnt(0)" ::: "memory");
            if (l2 == 0) __hip_atomic_fetch_add(hcnt + pm, 1u, __ATOMIC_RELAXED, __HIP_MEMORY_SCOPE_AGENT); }
        else { bf16* Y = (bf16*)(a.ws + WS_Y);
#pragma unroll
            for (int m = 0; m < 8; ++m)
#pragma unroll
                for (int n = 0; n < 4; ++n) { const f32x4 v = acc[m][n]; u32x2 wv; wv.x = pk2(v[0], v[1]); wv.y = pk2(v[2], v[3]);
                    *(u32x2*)(Y + (row0 + 16 * m) * DM + pnl * 256 + 64 * wn + 16 * n + 4 * fq) = wv; } }
    }
}

__device__ __forceinline__ void ph_route_prep(const Args& a, const Ctx& X) {
    const float* mod = (const float*)(a.ws + WS_MOD); f32x4* WR2 = (f32x4*)(a.ws + WS_WR2); float* B2 = (float*)(a.ws + WS_BIAS2);
    { u32x4* WH = (u32x4*)(a.ws + WS_WR2);
      for (int idx = X.bid * NTHR + X.tid; idx < 2 * 64 * 3 * 64; idx += X.G * NTHR) {
        const int lane = idx & 63, nb = (idx >> 6) % 3, s = (idx / 192) & 63, b = idx / (192 * 64), n = 16 * nb + (lane & 15), k0 = 32 * s + 8 * (lane >> 4);
        float w[8];
#pragma unroll
        for (int j = 0; j < 8; ++j) { const int k = k0 + j; const float wv = n < 4 ? a.in[I_WGRP][k * 4 + n] : n < 36 ? a.in[I_WRTR][k * 32 + n - 4] : 0.f;
            w[j] = wv * a.in[I_NORM2][k] * (1.f + mod[b * 12288 + 4 * DM + k]); }
        u32x4 hi, lo;
#pragma unroll
        for (int p = 0; p < 4; ++p) { const unsigned h = pk2(w[2 * p], w[2 * p + 1]); hi[p] = h; lo[p] = pk2(w[2 * p] - bflo(h), w[2 * p + 1] - bfhi(h)); }
        WH[idx] = hi; WH[idx + 24576] = lo; } }
    if (X.wave == 0) for (int p = X.bid; p < 96; p += X.G) { const int b = p / 48, n = p % 48; float s = 0.f;
        if (n < 36) { const float* wp = n < 4 ? a.in[I_WGRP] + n : a.in[I_WRTR] + n - 4; const int ws_ = n < 4 ? 4 : 32;
#pragma unroll
            for (int i = 0; i < 32; ++i) { const int k = X.lane + 64 * i; s += mod[b * 12288 + 3 * DM + k] * wp[(size_t)k * ws_]; } }
        s = wave_sum(s); if (X.lane == 0) B2[p] = s; }
}
__device__ __forceinline__ void ph_route2(const Args& a, const Ctx& X) {
    const float* X1 = (const float*)(a.ws + WS_X1); const float* mod = (const float*)(a.ws + WS_MOD); bf16* H = (bf16*)(a.ws + WS_H);
    const f32x4* WR2 = (const f32x4*)(a.ws + WS_WR2); const float* B2 = (const float*)(a.ws + WS_BIAS2);
    int* toke = (int*)(a.ws + WS_TOKE); float* tokw = (float*)(a.ws + WS_TOKW);
    LAS float* PART = (LAS float*)X.lds;
    LAS float* SSP = PART + 8 * 16 * 48;
    LAS float* RSTD = SSP + 128;
    const int i = X.lane & 15, g = X.lane >> 4, tl = X.wave >> 2, kq = X.wave & 3;
    for (int tp = X.bid; tp < NTOK / 32; tp += X.G) {
        const int tok0 = tp * 32 + tl * 16, b = tok0 >> 12;
        f32x4 acc[3];
#pragma unroll
        for (int nb = 0; nb < 3; ++nb) acc[nb] = (f32x4){0.f, 0.f, 0.f, 0.f};
        float ss = 0.f;
        const float* xr = X1 + (size_t)(tok0 + i) * DM + kq * 512 + 8 * g; const u32x4* wh = (const u32x4*)(a.ws + WS_WR2) + (size_t)((b * 64 + kq * 16) * 3) * 64 + X.lane;
#pragma unroll 4
        for (int s = 0; s < 16; ++s) { const f32x4 x0 = *(const f32x4*)(xr + 32 * s), x1v = *(const f32x4*)(xr + 32 * s + 4);
            ss += ((x0[0] * x0[0] + x0[1] * x0[1]) + (x0[2] * x0[2] + x0[3] * x0[3])) + ((x1v[0] * x1v[0] + x1v[1] * x1v[1]) + (x1v[2] * x1v[2] + x1v[3] * x1v[3]));
            u32x4 xh, xl;
            xh[0] = pk2(x0[0], x0[1]); xh[1] = pk2(x0[2], x0[3]); xh[2] = pk2(x1v[0], x1v[1]); xh[3] = pk2(x1v[2], x1v[3]);
            xl[0] = pk2(x0[0] - bflo(xh[0]), x0[1] - bfhi(xh[0])); xl[1] = pk2(x0[2] - bflo(xh[1]), x0[3] - bfhi(xh[1]));
            xl[2] = pk2(x1v[0] - bflo(xh[2]), x1v[1] - bfhi(xh[2])); xl[3] = pk2(x1v[2] - bflo(xh[3]), x1v[3] - bfhi(xh[3]));
            const pg8::bf16x8 XH = __builtin_bit_cast(pg8::bf16x8, xh), XL = __builtin_bit_cast(pg8::bf16x8, xl);
#pragma unroll
            for (int nb = 0; nb < 3; ++nb) { const pg8::bf16x8 WHf = __builtin_bit_cast(pg8::bf16x8, wh[(s * 3 + nb) * 64]), WLf = __builtin_bit_cast(pg8::bf16x8, wh[(s * 3 + nb) * 64 + 24576]);
                acc[nb] = __builtin_amdgcn_mfma_f32_16x16x32_bf16(XL, WHf, acc[nb], 0, 0, 0); acc[nb] = __builtin_amdgcn_mfma_f32_16x16x32_bf16(XH, WLf, acc[nb], 0, 0, 0);
                acc[nb] = __builtin_amdgcn_mfma_f32_16x16x32_bf16(XH, WHf, acc[nb], 0, 0, 0); } }
        ss += __shfl_xor(ss, 16); ss += __shfl_xor(ss, 32);
#pragma unroll
        for (int nb = 0; nb < 3; ++nb)
#pragma unroll
            for (int r = 0; r < 4; ++r) PART[(X.wave * 16 + 4 * g + r) * 48 + 16 * nb + i] = acc[nb][r];
        if (g == 0) SSP[X.wave * 16 + i] = ss;
        __syncthreads();
        if (X.tid < 32) { const int tq = X.tid >> 4, tk = X.tid & 15, row = tp * 32 + X.tid;
            const float rstd = rsqrtf(((SSP[(tq * 4) * 16 + tk] + SSP[(tq * 4 + 1) * 16 + tk]) + (SSP[(tq * 4 + 2) * 16 + tk] + SSP[(tq * 4 + 3) * 16 + tk])) * (1.f / DM) + EPS);
            RSTD[X.tid] = rstd;
            float lg[36];
#pragma unroll
            for (int n = 0; n < 36; ++n) lg[n] = rstd * ((PART[((tq * 4) * 16 + tk) * 48 + n] + PART[((tq * 4 + 1) * 16 + tk) * 48 + n]) + (PART[((tq * 4 + 2) * 16 + tk) * 48 + n] + PART[((tq * 4 + 3) * 16 + tk) * 48 + n])) + B2[b * 48 + n];
            int gi = 0; float gmax = lg[0];
#pragma unroll
            for (int q = 1; q < 4; ++q) if (lg[q] > gmax) { gmax = lg[q]; gi = q; }
            float den = 0.f;
#pragma unroll
            for (int q = 0; q < 4; ++q) den += expf(lg[q] - gmax);
            const float pg = 1.f / den;
            float sl[8];
#pragma unroll
            for (int q = 0; q < 8; ++q) sl[q] = gi == 0 ? lg[4 + q] : gi == 1 ? lg[12 + q] : gi == 2 ? lg[20 + q] : lg[28 + q];
            int i0 = 0; float v0 = sl[0];
#pragma unroll
            for (int q = 1; q < 8; ++q) if (sl[q] > v0) { v0 = sl[q]; i0 = q; }
            int i1 = (i0 + 1) & 7; float v1 = -3.0e38f;
#pragma unroll
            for (int q = 0; q < 8; ++q) if (q != i0 && sl[q] > v1) { v1 = sl[q]; i1 = q; }
            const float e = expf(v1 - v0);
            toke[row * 2] = gi * 8 + i0; toke[row * 2 + 1] = gi * 8 + i1; tokw[row * 2] = pg / (1.f + e); tokw[row * 2 + 1] = pg * e / (1.f + e); }
        __syncthreads();
        for (int q = 0; q < 4; ++q) { const int tt = X.wave * 4 + q, row = tp * 32 + tt; f32x4 v[8];
#pragma unroll
            for (int j = 0; j < 8; ++j) v[j] = *(const f32x4*)(X1 + (size_t)row * DM + 4 * X.lane + 256 * j);
            const float* mb = mod + (row >> 12) * 12288;
            row_modulate(v, RSTD[tt], a.in[I_NORM2], mb + 3 * DM, mb + 4 * DM, X.lane);
#pragma unroll
            for (int j = 0; j < 8; ++j) { u32x2 w; w.x = pk2(v[j][0], v[j][1]); w.y = pk2(v[j][2], v[j][3]); *(u32x2*)(H + (size_t)row * DM + 4 * X.lane + 256 * j) = w; } }
        __syncthreads();
    }
}
__device__ __forceinline__ void ph_sort(const Args& a, const Ctx& X) {
    unsigned* ctl = (unsigned*)(a.ws + WS_CTL); const int* toke = (const int*)(a.ws + WS_TOKE); int* tokp = (int*)(a.ws + WS_TOKP); int* rowtok = (int*)(a.ws + WS_RTOK);
    LAS int* tot = (LAS int*)X.lds;
    LAS int* pre = tot + 32;
    LAS int* offs = tot + 64;
    LAS int* nbk = tot + 96;
    LAS int* lpos = tot + 128;
    const int RPB = (NTOK + X.G - 1) / X.G, r_lo = X.bid * RPB, r_hi = (r_lo + RPB < NTOK) ? r_lo + RPB : NTOK;
    if (X.tid < 64) tot[X.tid] = 0;
    __syncthreads();
    for (int j = X.tid; j < NTOK * 2; j += NTHR) { const int e = toke[j]; atomicAdd((int*)&tot[e], 1); if ((j >> 1) < r_lo) atomicAdd((int*)&pre[e], 1); }
    __syncthreads();
    if (X.tid == 0) { int o = 0; for (int e = 0; e < NEXP; ++e) { offs[e] = o; const int nb = (tot[e] + 255) >> 8; nbk[e] = nb; o += nb * 256; }
        if (X.bid == 0) ((int*)ctl)[CW_NU] = (o >> 8) * 8;
        for (int e = 0; e < NEXP; ++e) pre[e] += offs[e];
        for (int r = r_lo; r < r_hi; ++r) for (int k = 0; k < 2; ++k) { const int e = toke[r * 2 + k]; lpos[(r - r_lo) * 2 + k] = pre[e]++; } }
    __syncthreads();
    if (X.bid == 0 && X.tid < 256) { int2* tab = (int2*)(a.ws + WS_UTAB); const int x = X.tid & 7, e = X.tid >> 3, nb = nbk[e], pm0 = offs[e] >> 8;
        for (int rb = 0; rb < nb; ++rb) tab[8 * (pm0 + rb) + x] = make_int2(pm0 + rb, e * 8 + x); }
    for (int e = X.bid; e < NEXP; e += X.G) for (int i = tot[e] + X.tid; i < nbk[e] * 256; i += NTHR) rowtok[offs[e] + i] = 0;
    for (int i = X.tid; i < (r_hi - r_lo) * 2; i += NTHR) { const int pos = lpos[i]; tokp[r_lo * 2 + i] = pos; rowtok[pos] = r_lo + (i >> 1); }
}
__device__ __forceinline__ void ph_final(const Args& a, const Ctx& X) {
    const float* X1 = (const float*)(a.ws + WS_X1); const float* mod = (const float*)(a.ws + WS_MOD); const bf16* Y = (const bf16*)(a.ws + WS_Y);
    const float* tokw = (const float*)(a.ws + WS_TOKW); const int* tokp = (const int*)(a.ws + WS_TOKP);
    for (int row = X.gw; row < NTOK; row += X.NGW) {
        const float w0 = tokw[row * 2], w1 = tokw[row * 2 + 1]; const bf16* y0 = Y + (size_t)tokp[row * 2] * DM; const bf16* y1 = Y + (size_t)tokp[row * 2 + 1] * DM;
        const float* g2 = mod + (row >> 12) * 12288 + 5 * DM;
        f32x4 v[8]; float ss = 0.f;
#pragma unroll
        for (int j = 0; j < 8; ++j) { const int d = 4 * X.lane + 256 * j; const f32x4 xv = *(const f32x4*)(X1 + (size_t)row * DM + d), gv = *(const f32x4*)(g2 + d);
            const u32x2 p = *(const u32x2*)(y0 + d), q = *(const u32x2*)(y1 + d);
            f32x4 m; m[0] = w0 * bflo(p.x) + w1 * bflo(q.x); m[1] = w0 * bfhi(p.x) + w1 * bfhi(q.x); m[2] = w0 * bflo(p.y) + w1 * bflo(q.y); m[3] = w0 * bfhi(p.y) + w1 * bfhi(q.y);
            v[j] = xv + gv * m; ss += (v[j][0] * v[j][0] + v[j][1] * v[j][1]) + (v[j][2] * v[j][2] + v[j][3] * v[j][3]); }
        const float rstd = rsqrtf(wave_sum(ss) * (1.f / DM) + EPS);
#pragma unroll
        for (int j = 0; j < 8; ++j) { const int d = 4 * X.lane + 256 * j; *(f32x4*)(a.out + (size_t)row * DM + d) = v[j] * rstd * *(const f32x4*)(a.in[I_FNORM] + d); }
    }
}

__device__ __forceinline__ Ctx mkctx(LAS unsigned char* lds, int vb, int wave) { Ctx X; unsigned z = 0u; asm volatile("" : "+v"(z)); int l = (int)__builtin_amdgcn_mbcnt_hi(~0u, __builtin_amdgcn_mbcnt_lo(~0u, z)); asm volatile("" : "+v"(l));
    X.lds = lds; X.lane = l; X.wave = wave; X.tid = wave * 64 + l; X.bid = blockIdx.x; X.G = gridDim.x; X.gw = X.bid * NWAVES + X.wave; X.NGW = X.G * NWAVES; X.vb = vb; return X; }
constexpr int N_PHASES = 13;
__global__ void __launch_bounds__(NTHR, 2) hybrid_fwd(Args args) {
    extern __shared__ __attribute__((aligned(16))) unsigned char lds_raw[];
    Ctx X0; X0.lds = (LAS unsigned char*)lds_raw; X0.tid = threadIdx.x; X0.lane = X0.tid & 63; X0.wave = __builtin_amdgcn_readfirstlane(X0.tid >> 6);
    X0.bid = blockIdx.x; X0.G = gridDim.x; X0.gw = X0.bid * NWAVES + X0.wave; X0.NGW = X0.G * NWAVES;
    unsigned char* ws = args.ws;
    volatile LAS unsigned* MISC = (volatile LAS unsigned*)(X0.lds + MISC_OFF);
    for (int u = X0.tid; u < (LDS_BYTES - RING_BYTES) / 4; u += NTHR) ((LAS unsigned*)(X0.lds + RING_BYTES))[u] = 0u;
    __syncthreads();
    XcdBarrier bar; bar.bar = (unsigned*)(ws + WS_CTL) + CW_BAR; bar.x = 0; bar.st = nullptr;
    if (MK_N_LAUNCHES == 1) bar = xcd_barrier_post((unsigned*)(ws + WS_CTL) + CW_BAR, MISC + 8);
    X0.vb = X0.bid;
    if (MK_N_LAUNCHES == 1 && X0.tid == 0) { const unsigned xcc = xb_xcc_id(); MISC[12] = xcc; MISC[13] = xb_add((unsigned*)(ws + WS_CTL) + CW_RANK + 64 * xcc, 1u); }
    const int lo = args.ph_lo, hi = args.ph_hi, wave_s0 = X0.wave;
#define IN(k) (lo <= (k) && (k) < hi)
#define SEAM(k) do { if (IN(k) && IN((k) + 1)) xcd_barrier(bar, wave_s0 * 64 + (int)__builtin_amdgcn_mbcnt_hi(~0u, __builtin_amdgcn_mbcnt_lo(~0u, 0u))); } while (0)

    LAS unsigned char* const lds0 = X0.lds; const int wave_s = X0.wave;
    if (IN(0)) { ph_prologue(args, X0); }
    if (IN(1)) { const Ctx X = mkctx(lds0, X0.vb, wave_s);
        if (MK_N_LAUNCHES == 1) { if (X.wave == 0) { unsigned sp = 0; while (xb_ld((unsigned*)(ws + WS_CTL) + CW_MODC) < (unsigned)ada_early_chunks(X.G)) { __builtin_amdgcn_s_sleep(4); if (++sp > (1u << 22)) break; }
                __builtin_amdgcn_fence(__ATOMIC_ACQUIRE, "agent"); asm volatile("s_waitcnt vmcnt(0)" ::: "memory"); }
            __syncthreads(); }
        ph_norm1(args, X); if (!late_convert(X.G)) ph_route_prep(args, X); } SEAM(1);
    if (MK_N_LAUNCHES == 1) {
        unsigned* barw = (unsigned*)(ws + WS_CTL) + CW_BAR; bool uni = (X0.G % 8) == 0;
        for (int j = 0; j < 16; ++j) { const unsigned cnt = xb_ld(barw + XB_XCNT(j)); uni = uni && (cnt == (j < 8 ? (unsigned)X0.G / 8u : 0u)); }
        __syncthreads();
        if (uni) X0.vb = __builtin_amdgcn_readfirstlane((int)(MISC[13] * 8u + MISC[12]));
    }
    const int vb_ = X0.vb;
    if (IN(2)) { const Ctx X = mkctx(lds0, vb_, wave_s); pg8::Gemm g{(const bf16*)(ws + WS_H), (const bf16*)(ws + WS_WIN), NTOK, INC, DM}; pg8::StaticOrder S; S.init(NTOK, INC, X.G, X.vb);
        EpiIn E{ws, (const float*)(ws + WS_LB)}; pg8::gemm_phase<EpiIn, pg8::StaticOrder, true, true>(X.lds, g, S, E, X.tid);
        if (late_convert(X.G)) { const int rem = S.nwg % X.G, nsh = X.G - rem;
            if (X.vb >= rem) {
                if (ada_early_chunks(X.G) == 64) {
                    LAS float* cond = (LAS float*)X.lds; for (int i = X.tid; i < 4096; i += NTHR) { const float c = args.in[I_C][i]; cond[i] = c / (1.f + expf(-c)); }
                    __syncthreads();
                    for (int chunk = 64 + X.vb - rem; chunk < 192; chunk += nsh) ada_chunk(args, cond, (LAS float*)(X.lds + 16384), X.tid, chunk);
                    __syncthreads(); }
                convert_items(args, X.lds, X.wave, X.lane, CV_I0, CV_ALL, (X.vb - rem) * NWAVES + X.wave, nsh * NWAVES); } } } SEAM(2);
    if (IN(3)) { const Ctx X = mkctx(lds0, vb_, wave_s); if (late_convert(X.G)) ph_route_prep(args, X);
        ph_rg_local(args, X); ph_hg_local(args, X); } SEAM(3);
    if (IN(4)) { const Ctx X = mkctx(lds0, vb_, wave_s); ph_hg_scan(args, X); ph_rg_carry(args, X); } SEAM(4);
    if (IN(5)) { const Ctx X = mkctx(lds0, vb_, wave_s); ph_rg_out(args, X); ph_hg_out(args, X); } SEAM(5);
    if (IN(6)) { const Ctx X = mkctx(lds0, vb_, wave_s);
        { pg8::Gemm g{(const bf16*)(ws + WS_HGO), (const bf16*)(ws + WS_WPA), NTOK, DM, HW}; pg8::StaticOrder S; S.init(NTOK, DM, X.G, X.vb);
          EpiGate<0> E{(const bf16*)(ws + WS_SGA), nullptr, (bf16*)(ws + WS_YA), DM}; pg8::gemm_phase<EpiGate<0>, pg8::StaticOrder, true, true>(X.lds, g, S, E, X.tid); }
        asm volatile("s_waitcnt vmcnt(0)" ::: "memory"); __syncthreads();
        { pg8::Gemm g{(const bf16*)(ws + WS_RGO), (const bf16*)(ws + WS_WPB), NTOK, DM, HW}; pg8::StaticOrder S; S.init(NTOK, DM, X.G, X.vb);
          EpiGate<1> E{(const bf16*)(ws + WS_SGB), (const bf16*)(ws + WS_YA), (bf16*)(ws + WS_MRG), DM}; pg8::gemm_phase<EpiGate<1>, pg8::StaticOrder, true, true>(X.lds, g, S, E, X.tid); } } SEAM(7);
    if (IN(8)) { const Ctx X = mkctx(lds0, vb_, wave_s); pg8::Gemm g{(const bf16*)(ws + WS_MRG), (const bf16*)(ws + WS_WOUT), NTOK, DM, DM}; pg8::StaticOrder S; S.init(NTOK, DM, X.G, X.vb);
        EpiX1 E{args.in[I_X], (const float*)(ws + WS_MOD), (float*)(ws + WS_X1)}; pg8::gemm_phase<EpiX1, pg8::StaticOrder, true, true>(X.lds, g, S, E, X.tid); } SEAM(8);
    if (IN(9)) { const Ctx X = mkctx(lds0, vb_, wave_s); ph_route2(args, X); } SEAM(9);
    if (IN(10)) { const Ctx X = mkctx(lds0, vb_, wave_s); ph_sort(args, X); } SEAM(10);
    if (IN(11)) { const Ctx X = mkctx(lds0, vb_, wave_s); const int nu = __builtin_amdgcn_readfirstlane((int)xb_ld((unsigned*)(ws + WS_CTL) + CW_NU));
        moe_gemm<1>(args, X, nu, X.vb, 0);
        const long L2 = X.vb + (long)((nu - X.vb + X.G - 1) / X.G) * X.G;
        const Ctx Xd = mkctx(lds0, vb_, wave_s);
        moe_gemm<2>(args, Xd, nu, L2 < nu ? nu + 0 : L2, nu); } SEAM(11);
    if (IN(12)) { const Ctx X = mkctx(lds0, vb_, wave_s); ph_final(args, X); }
#undef IN
#undef SEAM
}

extern "C" void kernel_launch(void* const* d_in, const int* in_sizes, int n_in, void* d_out, int out_size, void* d_ws, size_t ws_size, hipStream_t stream) {
    static int grid = 0;
    if (grid == 0) {
        if (n_in != 25 || out_size != NTOK * DM || ws_size < WS_END) { fprintf(stderr, "kernel_launch: unexpected problem (n_in %d, out %d, ws %zu < %zu)\n", n_in, out_size, ws_size, (size_t)WS_END); grid = -1; return; }
        int dev = 0, cus = 0, per_cu = 0;
        if (hipGetDevice(&dev) != hipSuccess || hipDeviceGetAttribute(&cus, hipDeviceAttributeMultiprocessorCount, dev) != hipSuccess) { grid = -1; return; }
        if (hipFuncSetAttribute((const void*)hybrid_fwd, hipFuncAttributeMaxDynamicSharedMemorySize, LDS_BYTES) != hipSuccess) { fprintf(stderr, "kernel_launch: hipFuncSetAttribute failed\n"); grid = -1; return; }
        if (hipOccupancyMaxActiveBlocksPerMultiprocessor(&per_cu, (const void*)hybrid_fwd, NTHR, LDS_BYTES) != hipSuccess || per_cu < 1) fprintf(stderr, "kernel_launch: occupancy query says %d\n", per_cu);
        (void)hipGetLastError();
        grid = cus;
    }
    if (grid < 0) return;
    if (hipMemsetAsync((char*)d_ws + WS_CTL, 0, CTL_ZERO_BYTES, stream) != hipSuccess) return;
    Args a{};
    for (int i = 0; i < 25; ++i) a.in[i] = (const float*)d_in[i];
    a.out = (float*)d_out; a.ws = (unsigned char*)d_ws;
    if (MK_N_LAUNCHES == 1) { a.ph_lo = 0; a.ph_hi = N_PHASES; hipLaunchKernelGGL(hybrid_fwd, dim3(grid), dim3(NTHR), LDS_BYTES, stream, a); }
    else for (int p = 0; p < N_PHASES; ++p) { a.ph_lo = p; a.ph_hi = p + 1; hipLaunchKernelGGL(hybrid_fwd, dim3(grid), dim3(NTHR), LDS_BYTES, stream, a); }
}
```

```cpp
#include <hip/hip_runtime.h>
#include <cstdio>
#include <cstdint>

#ifndef MK_N_LAUNCHES
#define MK_N_LAUNCHES 1
#endif

namespace pg8 {
#define PG8_LAS __attribute__((address_space(3)))
typedef unsigned short bf16_t;
typedef short bf16x8 __attribute__((ext_vector_type(8)));
typedef float f32x4 __attribute__((ext_vector_type(4)));
typedef unsigned u32x4 __attribute__((ext_vector_type(4)));
constexpr int BM = 256, BK = 64, HALF = 128, HTB = HALF * BK * 2  , STAGE_BYTES = 8 * HTB, NXCD = 8, WGM = 8;

__host__ __device__ __forceinline__ int lds_byte(int r, int c) { const int st = (r >> 4) * 2 + (c >> 5), rr = r & 15, cc = c & 31, ob = rr * 64 + cc * 2; return st * 1024 + (ob ^ (((ob >> 9) & 1) << 5)); }
__host__ __device__ __forceinline__ void stage_rc(int b, int& R, int& C) { const int st = b / 1024, sb = b % 1024, swz = sb ^ (((sb >> 9) & 1) << 5); R = (st >> 1) * 16 + swz / 64; C = (st & 1) * 32 + (swz % 64) / 2; }
__host__ __device__ __forceinline__ int perm32(int rho) { const int n = rho >> 4, i = rho & 15; return 8 * (i >> 2) + 4 * n + (i & 3); }

struct Unit { int pm, pn, g; };
struct Gemm { const bf16_t* A; const bf16_t* Bt; int M, N, K; const bf16_t* A2 = nullptr; const bf16_t* Bt2 = nullptr; };

struct StaticOrder {
    int nM, nN, nwg, G, c;
    __host__ __device__ void init(int M, int N, int G_, int c_) { nM = M / BM; nN = N / BM; nwg = nM * nN; G = G_; c = c_; }
    __host__ __device__ bool next(int i, Unit& u) const {
        const long L = (long)i * G + c; if (L >= nwg) return false;
        int wgid = (int)L; { const int q = nwg / NXCD, r = nwg % NXCD, xcd = wgid % NXCD, off = wgid / NXCD; wgid = (xcd < r ? xcd * (q + 1) : r * (q + 1) + (xcd - r) * q) + off; }
        const int nig = WGM * nN, gid = wgid / nig, fm = gid * WGM, gsz = (nM - fm) < WGM ? (nM - fm) : WGM;
        u.pm = fm + ((wgid % nig) % gsz); u.pn = (wgid % nig) / gsz; u.g = 0; return true;
    }
    __device__ __forceinline__ void a_ready(const Unit&) const {}
    __device__ __forceinline__ void done(const Unit&) const {}
};
struct TwoOrder { StaticOrder s;
    __device__ bool next(int i, Unit& u) const { const int per = (s.nwg - s.c + s.G - 1) / s.G; if (i < per) return s.next(i, u); if (!s.next(i - per, u)) return false; u.g = 1; return true; }
    __device__ __forceinline__ void a_ready(const Unit&) const {} __device__ __forceinline__ void done(const Unit&) const {} };

typedef float f32x2c __attribute__((ext_vector_type(2)));
typedef __bf16 bf16x2c __attribute__((ext_vector_type(2)));
__device__ __forceinline__ unsigned cvt_pk_bf16(float lo, float hi) { const f32x2c f = {lo, hi}; const bf16x2c v = __builtin_convertvector(f, bf16x2c); return __builtin_bit_cast(unsigned, v); }
typedef float f32x2 __attribute__((ext_vector_type(2)));

template <class Epi, class Sched, bool ALIGN_EPI = false, bool SP2 = false>
__device__ __forceinline__ void gemm_phase(PG8_LAS unsigned char* lds, const Gemm g, const Sched& S, const Epi& E, const int tid  ) {
    const int wid = __builtin_amdgcn_readfirstlane(tid >> 6), lane = tid & 63, wr = wid >> 2, wc = wid & 3, fr = lane & 15, fq = lane >> 4;
    const int K = g.K, nt = K / BK;
    unsigned voffA[2], voffB[2];
#pragma unroll
    for (int i = 0; i < 2; ++i) { int R, C; stage_rc(tid * 16 + i * 8192, R, C); const int Rb = Epi::PERM ? ((R & ~31) + perm32(R & 31)) : R;
        voffA[i] = (unsigned)(R * K + C) * 2u; voffB[i] = (unsigned)(Rb * K + C) * 2u; }
    const size_t kstep = (size_t)(BK * 2);
    const size_t hstep = (size_t)HALF * K * 2;
    const size_t tstep = 2 * hstep;
    const unsigned ldsw = (unsigned)wid * 1024u;
    const int aoff = lds_byte(wr * 64 + fr, fq * 8), boff = lds_byte(wc * 32 + fr, fq * 8);
#define PG8_SA(b, h) (((b) * 2 + (h)) * HTB)
#define PG8_SB(b, h) ((4 + (b) * 2 + (h)) * HTB)
#define PG8_STAGE(bufoff, gbase, voff) do { _Pragma("unroll") for (int _i = 0; _i < 2; ++_i) \
        __builtin_amdgcn_global_load_lds((const unsigned*)((const char*)(gbase) + (voff)[_i]), (PG8_LAS unsigned*)(lds + (bufoff) + ldsw + _i * 8192), 16, 0, 0); } while (0)
#define PG8_LDA(dst, b, h) do { _Pragma("unroll") for (int m = 0; m < 4; ++m) _Pragma("unroll") for (int k = 0; k < 2; ++k) dst[m][k] = *(const PG8_LAS bf16x8*)(lds + PG8_SA(b, h) + aoff + m * 2048 + k * 1024); } while (0)
#define PG8_LDB(dst, b, h) do { _Pragma("unroll") for (int n = 0; n < 2; ++n) _Pragma("unroll") for (int k = 0; k < 2; ++k) dst[n][k] = *(const PG8_LAS bf16x8*)(lds + PG8_SB(b, h) + boff + n * 2048 + k * 1024); } while (0)
#define PG8_MMA(ai, bj, At, Bt) do { __builtin_amdgcn_s_setprio(1); _Pragma("unroll") for (int m = 0; m < 4; ++m) _Pragma("unroll") for (int n = 0; n < 2; ++n) _Pragma("unroll") for (int k = 0; k < 2; ++k) \
        acc[ai][bj][m][n] = __builtin_amdgcn_mfma_f32_16x16x32_bf16(Bt[n][k], At[m][k], acc[ai][bj][m][n], 0, 0, 0); __builtin_amdgcn_s_setprio(0); } while (0)
#define PG8_WAIT_V(n) asm volatile("s_waitcnt vmcnt(" #n ")" ::: "memory")
#define PG8_WAIT_L(n) asm volatile("s_waitcnt lgkmcnt(" #n ")" ::: "memory")
#define PG8_BAR __builtin_amdgcn_s_barrier()
#define PG8_SCHED __builtin_amdgcn_sched_barrier(0)
    Unit cur, nxt; int ui = 0;
    if (!S.next(0, cur)) return;
    f32x4 acc[2][2][4][2];
#pragma unroll
    for (int a = 0; a < 2; ++a)
#pragma unroll
        for (int b = 0; b < 2; ++b)
#pragma unroll
            for (int m = 0; m < 4; ++m)
#pragma unroll
                for (int n = 0; n < 2; ++n) acc[a][b][m][n] = (f32x4){0.f, 0.f, 0.f, 0.f};
    bf16x8 At[4][2], B0[2][2], B1[2][2];
    const char* cA = (const char*)(cur.g ? g.A2 : g.A) + (size_t)cur.pm * tstep; const char* cB = (const char*)(cur.g ? g.Bt2 : g.Bt) + (size_t)cur.pn * tstep;
    S.a_ready(cur);
    if constexpr (SP2) {
        PG8_STAGE(PG8_SB(0, 0), cB, voffB); PG8_STAGE(PG8_SB(0, 1), cB + hstep, voffB); PG8_STAGE(PG8_SA(0, 0), cA, voffA); PG8_STAGE(PG8_SA(0, 1), cA + hstep, voffA);
        if (wr == 1) PG8_BAR;
        PG8_WAIT_V(2); PG8_BAR;
        PG8_STAGE(PG8_SB(1, 0), cB + kstep, voffB); PG8_STAGE(PG8_SA(1, 0), cA + kstep, voffA); PG8_STAGE(PG8_SB(1, 1), cB + hstep + kstep, voffB);
        PG8_WAIT_V(6); PG8_BAR;
    } else {
        PG8_STAGE(PG8_SB(0, 0), cB, voffB); PG8_STAGE(PG8_SA(0, 0), cA, voffA); PG8_STAGE(PG8_SB(0, 1), cB + hstep, voffB); PG8_STAGE(PG8_SA(0, 1), cA + hstep, voffA);
        if (wr == 1) PG8_BAR;
        PG8_WAIT_V(4); PG8_BAR;
        PG8_STAGE(PG8_SB(1, 0), cB + kstep, voffB); PG8_STAGE(PG8_SA(1, 0), cA + kstep, voffA); PG8_STAGE(PG8_SB(1, 1), cB + hstep + kstep, voffB);
        PG8_WAIT_V(6); PG8_BAR;
    }
    for (;;) {
        const bool has_next = S.next(ui + 1, nxt);
        const char* nA = has_next ? (const char*)(nxt.g ? g.A2 : g.A) + (size_t)nxt.pm * tstep : cA; const char* nB = has_next ? (const char*)(nxt.g ? g.Bt2 : g.Bt) + (size_t)nxt.pn * tstep : cB;
        for (int t = 0; t < nt; t += 2) {
            const bool last = (t == nt - 2);
            const char* a1 = cA + (size_t)(t + 1) * kstep;
            const char* a2 = last ? nA : cA + (size_t)(t + 2) * kstep; const char* b2 = last ? nB : cB + (size_t)(t + 2) * kstep;
            const char* a3 = a2 + kstep; const char* b3 = b2 + kstep;
            if (last && has_next) S.a_ready(nxt);
            if constexpr (SP2) {
            PG8_LDB(B0, 0, 0); PG8_LDB(B1, 0, 1); PG8_SCHED; PG8_LDA(At, 0, 0); PG8_STAGE(PG8_SA(1, 1), a1 + hstep, voffA);
            PG8_WAIT_V(8); PG8_WAIT_L(0); PG8_BAR; PG8_MMA(0, 0, At, B0); PG8_MMA(0, 1, At, B1); PG8_BAR; PG8_SCHED;
            PG8_LDA(At, 0, 1); PG8_STAGE(PG8_SB(0, 0), b2, voffB); PG8_STAGE(PG8_SB(0, 1), b2 + hstep, voffB); PG8_STAGE(PG8_SA(0, 0), a2, voffA);
            PG8_WAIT_V(8); PG8_WAIT_L(0); PG8_BAR; PG8_MMA(1, 0, At, B0); PG8_MMA(1, 1, At, B1); PG8_BAR; PG8_SCHED;
            PG8_LDB(B0, 1, 0); PG8_LDB(B1, 1, 1); PG8_SCHED; PG8_LDA(At, 1, 0); PG8_STAGE(PG8_SA(0, 1), a2 + hstep, voffA);
            PG8_WAIT_V(8); PG8_WAIT_L(0); PG8_BAR; PG8_MMA(0, 0, At, B0); PG8_MMA(0, 1, At, B1); PG8_BAR; PG8_SCHED;
            PG8_LDA(At, 1, 1); PG8_STAGE(PG8_SB(1, 0), b3, voffB); PG8_STAGE(PG8_SB(1, 1), b3 + hstep, voffB); PG8_STAGE(PG8_SA(1, 0), a3, voffA);
            PG8_WAIT_V(8); PG8_WAIT_L(0); PG8_BAR; PG8_MMA(1, 0, At, B0); PG8_MMA(1, 1, At, B1); PG8_BAR; PG8_SCHED;
            } else {
            PG8_LDB(B0, 0, 0); PG8_SCHED; PG8_LDA(At, 0, 0); PG8_STAGE(PG8_SA(1, 1), a1 + hstep, voffA);
            PG8_WAIT_L(8); PG8_BAR; PG8_WAIT_L(0); PG8_MMA(0, 0, At, B0); PG8_BAR; PG8_SCHED;
            PG8_LDB(B1, 0, 1); PG8_STAGE(PG8_SB(0, 0), b2, voffB);
            PG8_BAR; PG8_WAIT_L(0); PG8_MMA(0, 1, At, B1); PG8_BAR;
            PG8_LDA(At, 0, 1); PG8_STAGE(PG8_SA(0, 0), a2, voffA);
            PG8_BAR; PG8_WAIT_L(0); PG8_MMA(1, 0, At, B0); PG8_BAR; PG8_SCHED;
            PG8_STAGE(PG8_SB(0, 1), b2 + hstep, voffB);
            PG8_WAIT_V(6); PG8_BAR; PG8_MMA(1, 1, At, B1); PG8_BAR;
            PG8_LDB(B0, 1, 0); PG8_SCHED; PG8_LDA(At, 1, 0); PG8_STAGE(PG8_SA(0, 1), a2 + hstep, voffA);
            PG8_WAIT_L(8); PG8_BAR; PG8_WAIT_L(0); PG8_MMA(0, 0, At, B0); PG8_BAR; PG8_SCHED;
            PG8_LDB(B1, 1, 1); PG8_STAGE(PG8_SB(1, 0), b3, voffB);
            PG8_BAR; PG8_WAIT_L(0); PG8_MMA(0, 1, At, B1); PG8_BAR;
            PG8_LDA(At, 1, 1); PG8_STAGE(PG8_SA(1, 0), a3, voffA);
            PG8_BAR; PG8_WAIT_L(0); PG8_MMA(1, 0, At, B0); PG8_BAR; PG8_SCHED;
            PG8_STAGE(PG8_SB(1, 1), b3 + hstep, voffB);
            PG8_WAIT_V(6); PG8_BAR; PG8_MMA(1, 1, At, B1); PG8_BAR;
            }
        }
        if constexpr (ALIGN_EPI) { if (wr == 0) PG8_BAR; }
        if constexpr (!Epi::AFTER_DRAIN) { E(acc, cur, wr, wc, fr, fq); S.done(cur); }
        if (!has_next) break;
#pragma unroll
        for (int a = 0; a < 2; ++a)
#pragma unroll
            for (int b = 0; b < 2; ++b)
#pragma unroll
                for (int m = 0; m < 4; ++m)
#pragma unroll
                    for (int n = 0; n < 2; ++n) acc[a][b][m][n] = (f32x4){0.f, 0.f, 0.f, 0.f};
        cur = nxt; cA = nA; cB = nB; ++ui;
        if constexpr (ALIGN_EPI) { if (wr == 1) PG8_BAR; }
    }
    PG8_WAIT_V(0);
    if constexpr (!ALIGN_EPI) { if (wr == 0) PG8_BAR; }
    PG8_BAR;
    if constexpr (Epi::AFTER_DRAIN) { E.fused(acc, cur, wr, wc, fr, fq, lds, wid, lane); S.done(cur); }
#undef PG8_SA
#undef PG8_SB
#undef PG8_STAGE
#undef PG8_LDA
#undef PG8_LDB
#undef PG8_MMA
#undef PG8_WAIT_V
#undef PG8_WAIT_L
#undef PG8_BAR
#undef PG8_SCHED
}
}

constexpr int NTOK = 8192, SEQ = 4096, DM = 2048, INC = 11264, HW = 1024, NEXP = 32, DEX = 1024;
constexpr float EPS = 1e-6f;
constexpr int NWAVES = 8, NTHR = 512;

constexpr size_t MiB = 1u << 20;
constexpr size_t WS_CTL = 0, CTL_ZERO_BYTES = 65536;
constexpr size_t WS_MOD = 1 * MiB;
constexpr size_t WS_LB = 1 * MiB + 128 * 1024;
constexpr size_t WS_UTAB = 1 * MiB + 256 * 1024;
constexpr size_t WS_TOKE = 2 * MiB;
constexpr size_t WS_TOKW = 2 * MiB + 64 * 1024;
constexpr size_t WS_TOKP = 2 * MiB + 128 * 1024;
constexpr size_t WS_RTOK = 2 * MiB + 256 * 1024;
constexpr size_t WS_BIAS2 = 1 * MiB + 192 * 1024;
constexpr size_t WS_WR2 = 3 * MiB;
constexpr size_t WS_WIN = 4 * MiB;
constexpr size_t WS_WPA = 48 * MiB, WS_WPB = 52 * MiB, WS_WOUT = 56 * MiB;
constexpr size_t WS_H = 448 * MiB;
constexpr size_t WS_X1 = 480 * MiB;
constexpr size_t WS_Q = 544 * MiB, WS_V = 560 * MiB, WS_GF = 576 * MiB, WS_GB = 608 * MiB, WS_GOUT = 640 * MiB, WS_RGX = 656 * MiB, WS_RGY = 672 * MiB, WS_SGA = 688 * MiB, WS_SGB = 720 * MiB;
constexpr size_t WS_HGO = 752 * MiB, WS_RGO = 768 * MiB, WS_YA = 784 * MiB, WS_MRG = 816 * MiB;
constexpr size_t WS_SA = 848 * MiB, WS_SU = 912 * MiB;
constexpr size_t WS_HID = 640 * MiB;
constexpr size_t WS_Y = 688 * MiB;
constexpr size_t WS_HL = 914 * MiB;
constexpr size_t WS_PP = 946 * MiB;
constexpr size_t WS_AE = 978 * MiB;
constexpr size_t WS_CIN = 980 * MiB;
constexpr size_t WS_WG = 981 * MiB;
constexpr size_t WS_END = 982 * MiB;
constexpr int CW_BAR = 4096, CW_NU = 8320, CW_RANK = 8448, CW_HID = 9600, CW_MODC = 9900  ;

constexpr int RING_BYTES = 131072, MISC_OFF = RING_BYTES + 320, LDS_BYTES = 147456;

#define GAS __attribute__((address_space(1)))
#define LAS __attribute__((address_space(3)))
typedef unsigned short bf16;
typedef float f32x4 __attribute__((ext_vector_type(4)));
typedef unsigned u32x4 __attribute__((ext_vector_type(4)));
typedef unsigned u32x2 __attribute__((ext_vector_type(2)));
#define LDS_WAIT() asm volatile("s_waitcnt lgkmcnt(0)" ::: "memory")
__device__ __forceinline__ float bf2f(unsigned b) { return __uint_as_float(b << 16); }
__device__ __forceinline__ float bflo(unsigned w) { return __uint_as_float(w << 16); }
__device__ __forceinline__ float bfhi(unsigned w) { return __uint_as_float(w & 0xffff0000u); }
__device__ __forceinline__ unsigned pk2(float lo, float hi) { return pg8::cvt_pk_bf16(lo, hi); }
__device__ __forceinline__ float fsigmoid(float x) { return __builtin_amdgcn_rcpf(1.f + __expf(-x)); }
__device__ __forceinline__ float fsilu(float x) { return x * fsigmoid(x); }
__device__ __forceinline__ float fgelu_tanh(float x) { const float u = 0.7978845608028654f * (x + 0.044715f * x * x * x); return x * fsigmoid(2.f * u); }
__device__ __forceinline__ float wave_sum(float v) {
#pragma unroll
    for (int o = 1; o < 64; o <<= 1) v += __shfl_xor(v, o);
    return v;
}

#define XB_TMO      128
#define XB_XCNT(j)  (256  + 64 * (j))
#define XB_XSUB(j)  (1280 + 64 * (j))
#define XB_XGEN(j)  (2304 + 64 * (j))
#define XB_TOP      3328
#define XB_TOPGEN   3392
#define XCD_BAR_WORDS 3456
#define XB_SPIN_CAP (1u << 18)
__device__ __forceinline__ unsigned xb_ld(unsigned* p)              { return __hip_atomic_load(p, __ATOMIC_RELAXED, __HIP_MEMORY_SCOPE_AGENT); }
__device__ __forceinline__ unsigned xb_add(unsigned* p, unsigned v) { return __hip_atomic_fetch_add(p, v, __ATOMIC_RELAXED, __HIP_MEMORY_SCOPE_AGENT); }
__device__ __forceinline__ unsigned xb_xcc_id() { return (unsigned)__builtin_amdgcn_s_getreg((3 << 11) | 20) & 0xFu; }
#define XB_SPIN(cond, bar) do { unsigned _sp = 0; while (cond) { __builtin_amdgcn_s_sleep(1); \
    if ((++_sp & 255u) == 0u) { if (xb_ld(&(bar)[XB_TMO])) break; if (_sp > XB_SPIN_CAP) { atomicAdd(&(bar)[XB_TMO], 1u); break; } } } } while (0)
struct XcdBarrier { unsigned* bar; unsigned x; volatile LAS unsigned* st; };
__device__ __forceinline__ XcdBarrier xcd_barrier_post(unsigned* bar, volatile LAS unsigned* st) {
    XcdBarrier b; b.bar = bar; b.x = xb_xcc_id(); b.st = st;
    if (threadIdx.x == 0) (void)xb_add(&bar[XB_XCNT(b.x)], 1u);
    return b;
}
__device__ __forceinline__ void xcd_barrier_complete(unsigned* bar, unsigned x, unsigned& nloc, unsigned& nx) {
    const unsigned G = gridDim.x * gridDim.y * gridDim.z;
    unsigned sum, cnt, mine, sp = 0u;
    for (;;) {
        sum = 0u; cnt = 0u; mine = 0u;
#pragma unroll
        for (unsigned j = 0; j < 16; ++j) { const unsigned c = xb_ld(&bar[XB_XCNT(j)]); sum += c; cnt += (c > 0u) ? 1u : 0u; mine = (j == x) ? c : mine; }
        if (sum == G) break;
        __builtin_amdgcn_s_sleep(1);
        if ((++sp & 255u) == 0u) { if (xb_ld(&bar[XB_TMO])) break; if (sp > XB_SPIN_CAP) { atomicAdd(&bar[XB_TMO], 1u); break; } }
    }
    nloc = mine > 0u ? mine : 1u; nx = cnt > 0u ? cnt : 1u;
}
__device__ __forceinline__ void xcd_barrier(const XcdBarrier& b, int tid) {
    asm volatile("s_waitcnt vmcnt(0)" ::: "memory");
    __syncthreads();
    if (tid == 0) {
        unsigned* bar = b.bar;
        __builtin_amdgcn_s_waitcnt(0);
        unsigned nloc = b.st[0], nx = b.st[1];
        if (nloc == 0u) { xcd_barrier_complete(bar, b.x, nloc, nx); b.st[0] = nloc; b.st[1] = nx; }
        const unsigned old = xb_add(&bar[XB_XSUB(b.x)], 1u);
        const unsigned gen = old / nloc;
        if (old + 1u == (gen + 1u) * nloc) {
            __builtin_amdgcn_fence(__ATOMIC_RELEASE, "agent");
            asm volatile("s_waitcnt vmcnt(0)" ::: "memory");
            const unsigned og = xb_add(&bar[XB_TOP], 1u);
            const unsigned tg = og / nx;
            if (og + 1u == (tg + 1u) * nx) xb_add(&bar[XB_TOPGEN], 1u);
            else XB_SPIN(xb_ld(&bar[XB_TOPGEN]) == tg, bar);
            __builtin_amdgcn_fence(__ATOMIC_ACQUIRE, "agent");
            xb_add(&bar[XB_XGEN(b.x)], 1u);
            asm volatile("s_waitcnt vmcnt(0)" ::: "memory");
        } else {
            XB_SPIN(xb_ld(&bar[XB_XGEN(b.x)]) == gen, bar);
            __builtin_amdgcn_fence(__ATOMIC_ACQUIRE, "agent");
            asm volatile("s_waitcnt vmcnt(0)" ::: "memory");
        }
    }
    __syncthreads();
}

struct Args { const float* in[25]; float* out; unsigned char* ws; int ph_lo, ph_hi; };
enum { I_X = 0, I_C, I_WADA, I_BADA, I_NORM1, I_WIN, I_HGLB, I_HGNORM, I_CONVW, I_CONVB, I_RGWA, I_RGBA, I_RGWX, I_RGBX, I_LAM, I_WPA, I_WPB, I_WOUT, I_NORM2, I_WGRP, I_WRTR, I_WGATE, I_WUP, I_WDOWN, I_FNORM };
struct Ctx { LAS unsigned char* lds; int tid, lane, wave, bid, G, gw, NGW, vb; };

struct EpiIn {
    static constexpr bool PERM = true, AFTER_DRAIN = false;
    unsigned char* ws; const float* LB;
    template <int MODE> __device__ __forceinline__ void body(const f32x4 (&acc)[2][2][4][2], void* basev, int ldc, int row0, int col0, const float* lbp) const {
        f32x4 lb[2][2];
        if (MODE == 2) {
#pragma unroll
            for (int bj = 0; bj < 2; ++bj)
#pragma unroll
                for (int n = 0; n < 2; ++n) lb[bj][n] = *(const f32x4*)(lbp + col0 + bj * 128 + 4 * n);
        }
#pragma unroll
        for (int ai = 0; ai < 2; ++ai)
#pragma unroll
            for (int m = 0; m < 4; ++m) {
                const size_t ro = (size_t)(row0 + ai * 128 + m * 16) * ldc + col0;
#pragma unroll
                for (int bj = 0; bj < 2; ++bj) {
                    f32x4 v0 = acc[ai][bj][m][0], v1 = acc[ai][bj][m][1];
                    if (MODE == 2) {
#pragma unroll
                        for (int j = 0; j < 4; ++j) { const float l0 = lb[bj][0][j], l1 = lb[bj][1][j];
                            v0[j] = __logf(l0 + (1.f - l0) * fsigmoid(v0[j])); v1[j] = __logf(l1 + (1.f - l1) * fsigmoid(v1[j])); }
                        float* p = (float*)basev + ro + bj * 128;
                        *(f32x4*)p = v0; *(f32x4*)(p + 4) = v1;
                    } else {
#pragma unroll
                        for (int j = 0; j < 4; ++j) {
                            if (MODE == 0) { v0[j] = fsilu(v0[j]); v1[j] = fsilu(v1[j]); }
                            if (MODE == 3) { v0[j] = fgelu_tanh(v0[j]); v1[j] = fgelu_tanh(v1[j]); }
                            if (MODE == 4) { v0[j] = fsigmoid(v0[j]); v1[j] = fsigmoid(v1[j]); }
                        }
                        u32x4 w; w.x = pk2(v0[0], v0[1]); w.y = pk2(v0[2], v0[3]); w.z = pk2(v1[0], v1[1]); w.w = pk2(v1[2], v1[3]);
                        *(u32x4*)((bf16*)basev + ro + bj * 128) = w;
                    }
                }
            }
    }
    __device__ __forceinline__ void operator()(const f32x4 (&acc)[2][2][4][2], const pg8::Unit& u, int wr, int wc, int fr, int fq) const {
        const int row0 = u.pm * 256 + wr * 64 + fr, pn = u.pn, cl = wc * 32 + 8 * fq;
        if (pn < 4)       body<0>(acc, ws + WS_Q, 1024, row0, pn * 256 + cl, nullptr);
        else if (pn < 8)  body<1>(acc, ws + WS_V, 1024, row0, (pn - 4) * 256 + cl, nullptr);
        else if (pn < 12) body<2>(acc, ws + WS_GF, 1024, row0, (pn - 8) * 256 + cl, LB);
        else if (pn < 16) body<2>(acc, ws + WS_GB, 1024, row0, (pn - 12) * 256 + cl, LB + 1024);
        else if (pn < 20) body<0>(acc, ws + WS_GOUT, 1024, row0, (pn - 16) * 256 + cl, nullptr);
        else if (pn < 24) body<1>(acc, ws + WS_RGX, 1024, row0, (pn - 20) * 256 + cl, nullptr);
        else if (pn < 28) body<3>(acc, ws + WS_RGY, 1024, row0, (pn - 24) * 256 + cl, nullptr);
        else              body<4>(acc, ws + (pn < 36 ? WS_SGA : WS_SGB), 2048, row0, ((pn - 28) & 7) * 256 + cl, nullptr);
    }
};
template <int MODE> struct EpiGate {
    static constexpr bool PERM = true, AFTER_DRAIN = false;
    const bf16* Gm; const bf16* P; bf16* O; int ldc;
    __device__ __forceinline__ void operator()(const f32x4 (&acc)[2][2][4][2], const pg8::Unit& u, int wr, int wc, int fr, int fq) const {
        const int row0 = u.pm * 256 + wr * 64 + fr, col0 = u.pn * 256 + wc * 32 + 8 * fq;
#pragma unroll
        for (int ai = 0; ai < 2; ++ai)
#pragma unroll
            for (int m = 0; m < 4; ++m) {
                const size_t ro = (size_t)(row0 + ai * 128 + m * 16) * ldc + col0;
#pragma unroll
                for (int bj = 0; bj < 2; ++bj) {
                    const u32x4 g = *(const u32x4*)(Gm + ro + bj * 128);
                    f32x4 v0 = acc[ai][bj][m][0], v1 = acc[ai][bj][m][1];
                    v0[0] *= bflo(g.x); v0[1] *= bfhi(g.x); v0[2] *= bflo(g.y); v0[3] *= bfhi(g.y);
                    v1[0] *= bflo(g.z); v1[1] *= bfhi(g.z); v1[2] *= bflo(g.w); v1[3] *= bfhi(g.w);
                    if (MODE == 1) { const u32x4 p = *(const u32x4*)(P + ro + bj * 128);
                        v0[0] += bflo(p.x); v0[1] += bfhi(p.x); v0[2] += bflo(p.y); v0[3] += bfhi(p.y);
                        v1[0] += bflo(p.z); v1[1] += bfhi(p.z); v1[2] += bflo(p.w); v1[3] += bfhi(p.w); }
                    u32x4 w; w.x = pk2(v0[0], v0[1]); w.y = pk2(v0[2], v0[3]); w.z = pk2(v1[0], v1[1]); w.w = pk2(v1[2], v1[3]);
                    *(u32x4*)(O + ro + bj * 128) = w;
                }
            }
    }
};
struct EpiGateBoth {
    static constexpr bool PERM = true, AFTER_DRAIN = false;
    EpiGate<0> e0; EpiGate<1> e1;
    __device__ __forceinline__ void operator()(const f32x4 (&acc)[2][2][4][2], const pg8::Unit& u, int wr, int wc, int fr, int fq) const { if (u.g) e1(acc, u, wr, wc, fr, fq); else e0(acc, u, wr, wc, fr, fq); }
};
struct EpiX1 {
    static constexpr bool PERM = false, AFTER_DRAIN = false;
    const float* x; const float* mod; float* X1;
    __device__ __forceinline__ void operator()(const f32x4 (&acc)[2][2][4][2], const pg8::Unit& u, int wr, int wc, int fr, int fq) const {
        const int row0 = u.pm * 256 + wr * 64 + fr, col0 = u.pn * 256 + wc * 32 + 4 * fq;
        const float* g1 = mod + (size_t)((u.pm * 256) >> 12) * 12288 + 2 * DM;
        f32x4 gv[2][2];
#pragma unroll
        for (int bj = 0; bj < 2; ++bj)
#pragma unroll
            for (int n = 0; n < 2; ++n) gv[bj][n] = *(const f32x4*)(g1 + col0 + bj * 128 + n * 16);
#pragma unroll
        for (int ai = 0; ai < 2; ++ai)
#pragma unroll
            for (int m = 0; m < 4; ++m) {
                const size_t ro = (size_t)(row0 + ai * 128 + m * 16) * DM + col0;
#pragma unroll
                for (int bj = 0; bj < 2; ++bj)
#pragma unroll
                    for (int n = 0; n < 2; ++n) { const f32x4 xv = *(const f32x4*)(x + ro + bj * 128 + n * 16);
                        *(f32x4*)(X1 + ro + bj * 128 + n * 16) = xv + gv[bj][n] * acc[ai][bj][m][n]; }
            }
    }
};
__device__ __forceinline__ void transpose_item(const float* W, int K, int N, bf16* WT, int k0, int n0, size_t dst_row0, LAS float* scr, int lane) {
    f32x4 v[8];
#pragma unroll
    for (int i = 0; i < 8; ++i) v[i] = *(const f32x4*)(W + (size_t)(k0 + (lane >> 3) + 8 * i) * N + n0 + 4 * (lane & 7));
#pragma unroll
    for (int i = 0; i < 8; ++i) { LAS float* d = scr + ((lane >> 3) + 8 * i) * 33 + 4 * (lane & 7); d[0] = v[i][0]; d[1] = v[i][1]; d[2] = v[i][2]; d[3] = v[i][3]; }
    LDS_WAIT(); asm volatile("" ::: "memory");
    const int c = lane & 7;
#pragma unroll
    for (int j = 0; j < 4; ++j) { const int n = (lane >> 3) + 8 * j; const LAS float* s = scr + (8 * c) * 33 + n;
        u32x4 o; o.x = pk2(s[0 * 33], s[1 * 33]); o.y = pk2(s[2 * 33], s[3 * 33]); o.z = pk2(s[4 * 33], s[5 * 33]); o.w = pk2(s[6 * 33], s[7 * 33]);
        *(u32x4*)(WT + (dst_row0 + n) * K + k0 + 8 * c) = o; }
    LDS_WAIT(); asm volatile("" ::: "memory");
}

constexpr int CV_I0 = 32 * 352, CV_I1 = 16 * 64, CV_I3 = 32 * 64, CV_ALL = CV_I0 + 2 * CV_I1 + CV_I3;
__device__ __forceinline__ void convert_items(const Args& a, LAS unsigned char* lds, int wave, int lane, int lo, int hi, int wi, int nw) {
    unsigned char* ws = a.ws; LAS float* scr = (LAS float*)(lds + wave * 16384);
    for (int it = lo + wi; it < hi; it += nw) {
        int r = it;
        if (r < CV_I0) { const int kb = r / 352, nb = r % 352; transpose_item(a.in[I_WIN], DM, INC, (bf16*)(ws + WS_WIN), kb * 64, nb * 32, (size_t)nb * 32, scr, lane); continue; } r -= CV_I0;
        if (r < CV_I1) { const int kb = r / 64, nb = r % 64; transpose_item(a.in[I_WPA], HW, DM, (bf16*)(ws + WS_WPA), kb * 64, nb * 32, (size_t)nb * 32, scr, lane); continue; } r -= CV_I1;
        if (r < CV_I1) { const int kb = r / 64, nb = r % 64; transpose_item(a.in[I_WPB], HW, DM, (bf16*)(ws + WS_WPB), kb * 64, nb * 32, (size_t)nb * 32, scr, lane); continue; } r -= CV_I1;
        { const int kb = r / 64, nb = r % 64; transpose_item(a.in[I_WOUT], DM, DM, (bf16*)(ws + WS_WOUT), kb * 64, nb * 32, (size_t)nb * 32, scr, lane); }
    }
}
__device__ __forceinline__ bool late_convert(int G) { return ((NTOK / 256) * (INC / 256)) % G != 0; }
__device__ __forceinline__ void ph_prologue(const Args& a, const Ctx& X) {
    unsigned char* ws = a.ws;
    LAS float* cond = (LAS float*)X.lds;
    LAS float* red = (LAS float*)(X.lds + 16384);
    for (int i = X.tid; i < 4096; i += NTHR) { const float c = a.in[I_C][i]; cond[i] = c / (1.f + expf(-c)); }
    __syncthreads();
    float* mod = (float*)(ws + WS_MOD);
    for (int chunk = X.bid; chunk < 192; chunk += X.G) {
        const int cg = X.tid & 15, rg = X.tid >> 4, col = chunk * 64 + cg * 4;
        f32x4 a0 = {0.f, 0.f, 0.f, 0.f}, a1 = {0.f, 0.f, 0.f, 0.f};
        const float* wp = a.in[I_WADA] + col;
#pragma unroll 8
        for (int d = rg; d < DM; d += 32) { const f32x4 w = *(const f32x4*)(wp + (size_t)d * 12288); a0 += w * cond[d]; a1 += w * cond[2048 + d]; }
        LAS float* rp = red + (rg * 16 + cg) * 8;
        rp[0] = a0[0]; rp[1] = a0[1]; rp[2] = a0[2]; rp[3] = a0[3]; rp[4] = a1[0]; rp[5] = a1[1]; rp[6] = a1[2]; rp[7] = a1[3];
        __syncthreads();
        if (X.tid < 128) { const int cg2 = X.tid >> 3, v = X.tid & 7; float s = 0.f;
            for (int r = 0; r < 32; ++r) s += red[(r * 16 + cg2) * 8 + v];
            const int b = v >> 2, colo = chunk * 64 + cg2 * 4 + (v & 3);
            __hip_atomic_store((unsigned*)&mod[b * 12288 + colo], __float_as_uint(s + a.in[I_BADA][colo]), __ATOMIC_RELAXED, __HIP_MEMORY_SCOPE_AGENT); }
        asm volatile("s_waitcnt vmcnt(0)" ::: "memory");
        __syncthreads();
        if (X.tid == 0) __hip_atomic_fetch_add((unsigned*)(ws + WS_CTL) + CW_MODC, 1u, __ATOMIC_RELAXED, __HIP_MEMORY_SCOPE_AGENT);
    }
    if (X.bid == (X.G > 200 ? 200 : 0)) {
        float* LB = (float*)(ws + WS_LB);
        for (int i = X.tid; i < 2048; i += NTHR) { const float l0 = a.in[I_HGLB][i], l1 = a.in[I_HGLB][2048 + i]; LB[i] = 1.f / (1.f + expf(l1 - l0)); }
    }
    __syncthreads();
    {
        bf16* WG = (bf16*)(ws + WS_WG);
        for (int p = X.bid * NTHR + X.tid; p < 65536; p += X.G * NTHR) { const int lane = p & 63, ks = (p >> 6) & 3, q = (p >> 8) & 3, w = (p >> 10) & 7, h = p >> 13, g = lane >> 4, i = lane & 15;
            const float* sw = a.in[(q & 1) ? I_RGWX : I_RGWA] + ((size_t)((q >> 1) * 8 + h) * 128 + 32 * ks + 8 * g) * 128 + 16 * w + i;
            u32x4 o; o.x = pk2(sw[0], sw[128]); o.y = pk2(sw[256], sw[384]); o.z = pk2(sw[512], sw[640]); o.w = pk2(sw[768], sw[896]); *(u32x4*)(WG + (size_t)p * 8) = o; }
    }
    convert_items(a, X.lds, X.wave, X.lane, 0, late_convert(X.G) ? CV_I0 : CV_ALL, X.gw, X.NGW);
}

__device__ __forceinline__ float row_load_ss(const float* xrow, int lane, f32x4 (&v)[8]) {
    float s = 0.f;
#pragma unroll
    for (int j = 0; j < 8; ++j) { v[j] = *(const f32x4*)(xrow + 4 * lane + 256 * j); s += (v[j][0] * v[j][0] + v[j][1] * v[j][1]) + (v[j][2] * v[j][2] + v[j][3] * v[j][3]); }
    return wave_sum(s);
}
__device__ __forceinline__ void row_modulate(f32x4 (&v)[8], float rstd, const float* gain, const float* shift, const float* scale, int lane) {
#pragma unroll
    for (int j = 0; j < 8; ++j) { const int d = 4 * lane + 256 * j; const f32x4 g = *(const f32x4*)(gain + d), sh = *(const f32x4*)(shift + d), sc = *(const f32x4*)(scale + d);
        v[j] = v[j] * rstd * g * (sc + 1.f) + sh; }
}
__device__ __forceinline__ void ph_norm1(const Args& a, const Ctx& X) {
    const float* mod = (const float*)(a.ws + WS_MOD); bf16* H = (bf16*)(a.ws + WS_H);
    for (int row = X.gw; row < NTOK; row += X.NGW) {
        f32x4 v[8]; const float ss = row_load_ss(a.in[I_X] + (size_t)row * DM, X.lane, v);
        const float rstd = rsqrtf(ss * (1.f / DM) + EPS); const float* mb = mod + (row >> 12) * 12288;
        row_modulate(v, rstd, a.in[I_NORM1], mb, mb + DM, X.lane);
#pragma unroll
        for (int j = 0; j < 8; ++j) { u32x2 w; w.x = pk2(v[j][0], v[j][1]); w.y = pk2(v[j][2], v[j][3]); *(u32x2*)(H + (size_t)row * DM + 4 * X.lane + 256 * j) = w; }
    }
}


typedef short s16x4 __attribute__((ext_vector_type(4)));
#define MFMA16(a, b, c) __builtin_amdgcn_mfma_f32_16x16x32_bf16((a), (b), (c), 0, 0, 0)
__device__ __forceinline__ pg8::bf16x8 tr_frag(unsigned addr0, int RS, int lane) {
    const unsigned a0 = addr0 + (unsigned)((8 * (lane >> 4) + ((lane & 15) >> 2)) * RS + 8 * (lane & 3)), a1 = a0 + 4u * (unsigned)RS;
    s16x4 lo, hi;
    asm volatile("ds_read_b64_tr_b16 %0, %2\n\tds_read_b64_tr_b16 %1, %3\n\ts_waitcnt lgkmcnt(0)" : "=&v"(lo), "=&v"(hi) : "v"(a0), "v"(a1) : "memory");
    return __builtin_shufflevector(lo, hi, 0, 1, 2, 3, 4, 5, 6, 7);
}
__device__ __forceinline__ void tr_frag4(unsigned b0, unsigned b1, unsigned b2, unsigned b3, int RS, int lane, pg8::bf16x8 (&out)[4]) {
    const unsigned off = (unsigned)((8 * (lane >> 4) + ((lane & 15) >> 2)) * RS + 8 * (lane & 3)), r4 = 4u * (unsigned)RS;
    const unsigned a0 = b0 + off, a1 = b1 + off, a2 = b2 + off, a3 = b3 + off;
    s16x4 l0, h0, l1, h1, l2, h2, l3, h3;
    asm volatile("ds_read_b64_tr_b16 %0, %1" : "=v"(l0) : "v"(a0) : "memory"); asm volatile("ds_read_b64_tr_b16 %0, %1" : "=v"(h0) : "v"(a0 + r4) : "memory");
    asm volatile("ds_read_b64_tr_b16 %0, %1" : "=v"(l1) : "v"(a1) : "memory"); asm volatile("ds_read_b64_tr_b16 %0, %1" : "=v"(h1) : "v"(a1 + r4) : "memory");
    asm volatile("ds_read_b64_tr_b16 %0, %1" : "=v"(l2) : "v"(a2) : "memory"); asm volatile("ds_read_b64_tr_b16 %0, %1" : "=v"(h2) : "v"(a2 + r4) : "memory");
    asm volatile("ds_read_b64_tr_b16 %0, %1" : "=v"(l3) : "v"(a3) : "memory"); asm volatile("ds_read_b64_tr_b16 %0, %1" : "=v"(h3) : "v"(a3 + r4) : "memory");
    asm volatile("s_waitcnt lgkmcnt(0)" : "+v"(l0), "+v"(h0), "+v"(l1), "+v"(h1), "+v"(l2), "+v"(h2), "+v"(l3), "+v"(h3) :: "memory");
    out[0] = __builtin_shufflevector(l0, h0, 0, 1, 2, 3, 4, 5, 6, 7); out[1] = __builtin_shufflevector(l1, h1, 0, 1, 2, 3, 4, 5, 6, 7);
    out[2] = __builtin_shufflevector(l2, h2, 0, 1, 2, 3, 4, 5, 6, 7); out[3] = __builtin_shufflevector(l3, h3, 0, 1, 2, 3, 4, 5, 6, 7);
}
constexpr int HRS = 272, PRS = 144;
constexpr int HL_VS = 0, HL_QD = 17408, HL_KH2 = 34816, HL_QT2 = 52224, HL_KH1 = 60928, HL_PS = 69632, HL_TOT = 78848, HL_BND = 80896, HL_PART = 81408;
__device__ __forceinline__ void lds_st_bf16(LAS unsigned char* p, float v) { *(LAS unsigned short*)p = (unsigned short)(pk2(v, 0.f) & 0xffffu); }
__device__ __forceinline__ void hg_load_v(const bf16* V, int row_base, int col_base, LAS unsigned char* lds, int tid) {
#pragma unroll
    for (int i = 0; i < 2; ++i) { const int ch = tid + NTHR * i, r = ch >> 4, c = ch & 15;
        *(LAS u32x4*)(lds + HL_VS + r * HRS + c * 16) = *(const u32x4*)(V + (size_t)(row_base + r) * HW + col_base + c * 8); }
}
__device__ __forceinline__ void ph_hg_local(const Args& a, const Ctx& X) {
    const bf16* V = (const bf16*)(a.ws + WS_V); bf16* SB = (bf16*)(a.ws + WS_SA); float* DEC = (float*)(a.ws + WS_SU);
    LAS unsigned char* lds = X.lds; LAS float* TOT = (LAS float*)(lds + HL_TOT);
    const int k = X.tid & 127, ts = X.tid >> 7, fr = X.lane & 15, fq = X.lane >> 4;
    for (int u = X.bid; u < 2048; u += X.G) {
        const int c = u & 63, h = (u >> 6) & 7, b = (u >> 9) & 1, dir = u >> 10, row_base = b * SEQ + c * 64, col_base = h * 128;
        const float* Gp = (const float*)(a.ws + (dir ? WS_GB : WS_GF)) + (size_t)row_base * HW + col_base + k;
        hg_load_v(V, row_base, col_base, lds, X.tid);
        float g[16], cs[16]; float s = 0.f;
#pragma unroll
        for (int i = 0; i < 16; ++i) { const int r = dir ? 63 - (16 * ts + i) : 16 * ts + i; g[i] = Gp[(size_t)r * HW]; }
#pragma unroll
        for (int i = 0; i < 16; ++i) { s += g[i]; cs[i] = s; }
        TOT[ts * 128 + k] = s;
        __syncthreads();
        const float t0 = TOT[k], t1 = TOT[128 + k], t2 = TOT[256 + k], t3 = TOT[384 + k], tot = (t0 + t1) + (t2 + t3);
        const float off = ts == 0 ? 0.f : ts == 1 ? t0 : ts == 2 ? t0 + t1 : (t0 + t1) + t2;
#pragma unroll
        for (int i = 0; i < 16; ++i) { const int r = dir ? 63 - (16 * ts + i) : 16 * ts + i;
            const float kd = (1.f - __expf(g[i])) * __expf(tot - (off + cs[i]));
            lds_st_bf16(lds + HL_QD + r * HRS + k * 2, kd); }
        if (ts == 0) DEC[(size_t)u * 128 + k] = __expf(tot);
        __syncthreads();
        f32x4 acc[8];
#pragma unroll
        for (int j = 0; j < 8; ++j) acc[j] = (f32x4){0.f, 0.f, 0.f, 0.f};
        const int kb = X.wave;
#pragma unroll
        for (int rs = 0; rs < 2; ++rs) { const pg8::bf16x8 af = tr_frag((unsigned)(HL_QD + 32 * rs * HRS + 16 * kb * 2), HRS, X.lane);
            pg8::bf16x8 bv[2][4]; const unsigned vb0 = (unsigned)(HL_VS + 32 * rs * HRS);
            tr_frag4(vb0, vb0 + 32, vb0 + 64, vb0 + 96, HRS, X.lane, bv[0]); tr_frag4(vb0 + 128, vb0 + 160, vb0 + 192, vb0 + 224, HRS, X.lane, bv[1]);
#pragma unroll
            for (int j = 0; j < 8; ++j) acc[j] = MFMA16(af, bv[j >> 2][j & 3], acc[j]); }
        bf16* so = SB + (size_t)u * 16384;
#pragma unroll
        for (int j = 0; j < 8; ++j) { u32x2 w; w.x = pk2(acc[j][0], acc[j][1]); w.y = pk2(acc[j][2], acc[j][3]);
            *(u32x2*)(so + (((kb >> 1) * 8 + j) * 64 + (2 * (kb & 1) + (fq >> 1)) * 16 + fr) * 8 + 4 * (fq & 1)) = w; }
        __syncthreads();
    }
}
__device__ __forceinline__ void ph_hg_scan(const Args& a, const Ctx& X) {
    bf16* SB = (bf16*)(a.ws + WS_SA); const float* DEC = (const float*)(a.ws + WS_SU);
    if (X.tid < 256)
        for (int gid = X.bid * 256 + X.tid; gid < 65536; gid += X.G * 256) {
            const int seq = gid >> 11, e8 = gid & 2047, dir = seq >> 4, k0 = 32 * (e8 >> 9) + 8 * ((e8 & 63) >> 4);
            float s[8];
#pragma unroll
            for (int j = 0; j < 8; ++j) s[j] = 0.f;
#pragma unroll 4
            for (int cc = 0; cc < 64; ++cc) { const int c = dir ? 63 - cc : cc; const size_t un = (size_t)seq * 64 + c;
                u32x4* p = (u32x4*)(SB + un * 16384 + (size_t)e8 * 8); const u32x4 loc = *p;
                const f32x4 d0 = *(const f32x4*)(DEC + un * 128 + k0), d1 = *(const f32x4*)(DEC + un * 128 + k0 + 4);
                u32x4 o; o.x = pk2(s[0], s[1]); o.y = pk2(s[2], s[3]); o.z = pk2(s[4], s[5]); o.w = pk2(s[6], s[7]); *p = o;
                s[0] = d0[0] * s[0] + bflo(loc.x); s[1] = d0[1] * s[1] + bfhi(loc.x); s[2] = d0[2] * s[2] + bflo(loc.y); s[3] = d0[3] * s[3] + bfhi(loc.y);
                s[4] = d1[0] * s[4] + bflo(loc.z); s[5] = d1[1] * s[5] + bfhi(loc.z); s[6] = d1[2] * s[6] + bflo(loc.w); s[7] = d1[3] * s[7] + bfhi(loc.w); }
        }
}
__device__ __forceinline__ void ph_hg_out(const Args& a, const Ctx& X) {
    const bf16* Q = (const bf16*)(a.ws + WS_Q); const bf16* V = (const bf16*)(a.ws + WS_V); const bf16* SB = (const bf16*)(a.ws + WS_SA);
    const bf16* GO = (const bf16*)(a.ws + WS_GOUT); bf16* HGO = (bf16*)(a.ws + WS_HGO);
    LAS unsigned char* lds = X.lds; LAS float* TOT = (LAS float*)(lds + HL_TOT); LAS float* BND = (LAS float*)(lds + HL_BND); LAS float* PART = (LAS float*)(lds + HL_PART);
    const int k = X.tid & 127, ts = X.tid >> 7, fr = X.lane & 15, fq = X.lane >> 4, rb = X.wave & 3, dvh = X.wave >> 2;
    for (int u = X.bid; u < 1024; u += X.G) {
        const int c = u & 63, h = (u >> 6) & 7, b = u >> 9, row_base = b * SEQ + c * 64, col_base = h * 128;
        hg_load_v(V, row_base, col_base, lds, X.tid);
        f32x4 O[4];
#pragma unroll
        for (int j = 0; j < 4; ++j) O[j] = (f32x4){0.f, 0.f, 0.f, 0.f};
        for (int dir = 0; dir < 2; ++dir) {
            const float* Gp = (const float*)(a.ws + (dir ? WS_GB : WS_GF)) + (size_t)row_base * HW + col_base + k;
            const bf16* Qp = Q + (size_t)row_base * HW + col_base + k;
            float g[16], cs[16], qv[16]; float s = 0.f;
#pragma unroll
            for (int i = 0; i < 16; ++i) { const int r = dir ? 63 - (16 * ts + i) : 16 * ts + i; g[i] = Gp[(size_t)r * HW]; qv[i] = bf2f(Qp[(size_t)r * HW]); }
#pragma unroll
            for (int i = 0; i < 16; ++i) { s += g[i]; cs[i] = s; }
            TOT[ts * 128 + k] = s;
            __syncthreads();
            const float t0 = TOT[k], t1 = TOT[128 + k], t2 = TOT[256 + k];
            const float off = ts == 0 ? 0.f : ts == 1 ? t0 : ts == 2 ? t0 + t1 : (t0 + t1) + t2, bnd = t0 + t1;
            const int sec_row0 = dir ? 0 : 32, first_row0 = dir ? 32 : 0;
#pragma unroll
            for (int i = 0; i < 16; ++i) { const int r = dir ? 63 - (16 * ts + i) : 16 * ts + i; const float C = off + cs[i], kk = 1.f - __expf(g[i]);
                lds_st_bf16(lds + HL_QD + r * HRS + k * 2, qv[i] * __expf(C));
                lds_st_bf16(lds + HL_KH2 + r * HRS + k * 2, kk * __expf(fminf(bnd - C, 80.f)));
                if (ts >= 2) lds_st_bf16(lds + HL_QT2 + (r - sec_row0) * HRS + k * 2, qv[i] * __expf(C - bnd));
                else         lds_st_bf16(lds + HL_KH1 + (r - first_row0) * HRS + k * 2, kk * __expf(fminf(-C, 80.f))); }
            __syncthreads();
            const bf16* sp = SB + ((size_t)((dir * 2 + b) * 8 + h) * 64 + c) * 16384;
            pg8::bf16x8 Sf[4][4];
#pragma unroll
            for (int ks = 0; ks < 4; ++ks)
#pragma unroll
                for (int j = 0; j < 4; ++j) Sf[ks][j] = *(const pg8::bf16x8*)(sp + ((ks * 8 + 4 * dvh + j) * 64 + X.lane) * 8);
#pragma unroll
            for (int ub = 0; ub < 2; ++ub) { const int blk = 2 * X.wave + ub, tb = blk >> 2, sb = blk & 3;
                const bool allowed = dir ? (sb >= tb) : (sb <= tb), tfirst = dir ? (tb >= 2) : (tb < 2);
                f32x4 p = {0.f, 0.f, 0.f, 0.f};
                if (allowed) {
                    const int qoff = tfirst ? HL_QD + (16 * tb + fr) * HRS : HL_QT2 + (16 * tb - sec_row0 + fr) * HRS;
                    const int koff = tfirst ? HL_KH1 + (16 * sb - first_row0 + fr) * HRS : HL_KH2 + (16 * sb + fr) * HRS;
#pragma unroll
                    for (int ks = 0; ks < 4; ++ks) { const pg8::bf16x8 qf = *(const LAS pg8::bf16x8*)(lds + qoff + ks * 64 + fq * 16), kf = *(const LAS pg8::bf16x8*)(lds + koff + ks * 64 + fq * 16);
                        p = MFMA16(kf, qf, p); }
                    if (tb == sb) {
#pragma unroll
                        for (int j = 0; j < 4; ++j) { const bool keep = dir ? (4 * fq + j >= fr) : (4 * fq + j <= fr); p[j] = keep ? p[j] : 0.f; } }
                }
                u32x2 w; w.x = pk2(p[0], p[1]); w.y = pk2(p[2], p[3]);
                *(LAS u32x2*)(lds + HL_PS + (16 * tb + fr) * PRS + (16 * sb + 4 * fq) * 2) = w; }
            __syncthreads();
#pragma unroll
            for (int ks = 0; ks < 2; ++ks) { const pg8::bf16x8 pf = *(const LAS pg8::bf16x8*)(lds + HL_PS + (16 * rb + fr) * PRS + ks * 64 + fq * 16);
                { pg8::bf16x8 vf[4]; const unsigned vb0 = (unsigned)(HL_VS + 32 * ks * HRS + 128 * dvh); tr_frag4(vb0, vb0 + 32, vb0 + 64, vb0 + 96, HRS, X.lane, vf);
#pragma unroll
                for (int j = 0; j < 4; ++j) O[j] = MFMA16(vf[j], pf, O[j]); } }
#pragma unroll
            for (int ks = 0; ks < 4; ++ks) { const pg8::bf16x8 qf = *(const LAS pg8::bf16x8*)(lds + HL_QD + (16 * rb + fr) * HRS + ks * 64 + fq * 16);
#pragma unroll
                for (int j = 0; j < 4; ++j) O[j] = MFMA16(Sf[ks][j], qf, O[j]); }
            __syncthreads();
        }
        float ss = 0.f;
#pragma unroll
        for (int j = 0; j < 4; ++j) ss += (O[j][0] * O[j][0] + O[j][1] * O[j][1]) + (O[j][2] * O[j][2] + O[j][3] * O[j][3]);
        ss += __shfl_xor(ss, 16); ss += __shfl_xor(ss, 32);
        if (fq == 0) PART[dvh * 64 + 16 * rb + fr] = ss;
        __syncthreads();
        const float rstd = rsqrtf((PART[16 * rb + fr] + PART[64 + 16 * rb + fr]) * (1.f / 128.f) + EPS);
        const size_t ro = (size_t)(row_base + 16 * rb + fr) * HW + col_base;
#pragma unroll
        for (int j = 0; j < 4; ++j) { const int dv = 16 * (4 * dvh + j) + 4 * fq; const f32x4 nm = *(const f32x4*)(a.in[I_HGNORM] + col_base + dv); const u32x2 gg = *(const u32x2*)(GO + ro + dv);
            const f32x4 t = O[j] * rstd * nm; u32x2 w; w.x = pk2(t[0] * bflo(gg.x), t[1] * bfhi(gg.x)); w.y = pk2(t[2] * bflo(gg.y), t[3] * bfhi(gg.y));
            *(u32x2*)(HGO + ro + dv) = w; }
        __syncthreads();
    }
}

constexpr int RL_XC = 0, RL_XF = 17408, XFS = 132;
template <bool REV> __device__ __forceinline__ void rg_chunk_scan(const float (&av)[4][4], const float (&uv)[4][4], float (&hh)[4][4], float (&pp)[4][4], float& Aend, float& Eend, int lane) {
    const int fq = lane >> 4; float As[4], Hs[4];
#pragma unroll
    for (int rb = 0; rb < 4; ++rb) { float h = 0.f, p = 1.f;
#pragma unroll
        for (int ri = 0; ri < 4; ++ri) { const int reg = REV ? 3 - ri : ri; h = av[rb][reg] * h + uv[rb][reg]; p *= av[rb][reg]; hh[rb][reg] = h; pp[rb][reg] = p; }
        As[rb] = p; Hs[rb] = h; }
    const int n1 = REV ? lane + 16 : lane - 16, n2 = REV ? lane + 32 : lane - 32;
    const bool ok1 = REV ? (fq <= 2) : (fq >= 1), ok2 = REV ? (fq <= 1) : (fq >= 2);
    float cA = 1.f, cH = 0.f;
#pragma unroll
    for (int rbi = 0; rbi < 4; ++rbi) { const int rb = REV ? 3 - rbi : rbi; float A1 = As[rb], H1 = Hs[rb];
        { const float Ap = __shfl(A1, n1 & 63), Hp = __shfl(H1, n1 & 63); if (ok1) { H1 = A1 * Hp + H1; A1 = Ap * A1; } }
        { const float Ap = __shfl(A1, n2 & 63), Hp = __shfl(H1, n2 & 63); if (ok2) { H1 = A1 * Hp + H1; A1 = Ap * A1; } }
        float Ae = __shfl(A1, n1 & 63), He = __shfl(H1, n1 & 63); if (!ok1) { Ae = 1.f; He = 0.f; }
        const int tl = (REV ? 0 : 48) + (lane & 15); const float At = __shfl(A1, tl), Ht = __shfl(H1, tl);
        const float Hin = Ae * cH + He, Ain = cA * Ae;
#pragma unroll
        for (int reg = 0; reg < 4; ++reg) { hh[rb][reg] += pp[rb][reg] * Hin; pp[rb][reg] *= Ain; }
        cH = At * cH + Ht; cA = cA * At; }
    Aend = cA; Eend = cH;
}
__device__ __forceinline__ void ph_rg_local(const Args& a, const Ctx& X) {
    const bf16* RGX = (const bf16*)(a.ws + WS_RGX); const bf16* WG = (const bf16*)(a.ws + WS_WG);
    float* HL = (float*)(a.ws + WS_HL); unsigned* PP = (unsigned*)(a.ws + WS_PP); float2* AE = (float2*)(a.ws + WS_AE);
    LAS unsigned char* lds = X.lds; LAS float* XF = (LAS float*)(lds + RL_XF);
    const int w = X.wave, fr = X.lane & 15, fq = X.lane >> 4;
    for (int u = X.bid; u < 1024; u += X.G) {
        const int h = u & 7, c = (u >> 3) & 63, b = u >> 9, row_base = b * SEQ + c * 64, col_base = h * 128;
        pg8::bf16x8 Wf[4][4];
#pragma unroll
        for (int q = 0; q < 4; ++q)
#pragma unroll
            for (int ks = 0; ks < 4; ++ks) Wf[q][ks] = *(const pg8::bf16x8*)(WG + ((size_t)((h * 8 + w) * 16 + q * 4 + ks) * 64 + X.lane) * 8);
#pragma unroll
        for (int it = 0; it < 2; ++it) { const int item = X.tid + NTHR * it, r = item >> 4, c8 = item & 15, ch0 = col_base + c8 * 8;
            f32x4 s0 = *(const f32x4*)(a.in[I_CONVB] + ch0), s1 = *(const f32x4*)(a.in[I_CONVB] + ch0 + 4);
#pragma unroll
            for (int j = 0; j < 4; ++j) { const int s = c * 64 + r - 2 + j;
                if (s >= 0 && s < SEQ) { const u32x4 xv = *(const u32x4*)(RGX + (size_t)(b * SEQ + s) * HW + ch0);
                    const f32x4 w0 = *(const f32x4*)(a.in[I_CONVW] + j * 1024 + ch0), w1 = *(const f32x4*)(a.in[I_CONVW] + j * 1024 + ch0 + 4);
                    s0[0] += w0[0] * bflo(xv.x); s0[1] += w0[1] * bfhi(xv.x); s0[2] += w0[2] * bflo(xv.y); s0[3] += w0[3] * bfhi(xv.y);
                    s1[0] += w1[0] * bflo(xv.z); s1[1] += w1[1] * bfhi(xv.z); s1[2] += w1[2] * bflo(xv.w); s1[3] += w1[3] * bfhi(xv.w); } }
            u32x4 pk; pk.x = pk2(s0[0], s0[1]); pk.y = pk2(s0[2], s0[3]); pk.z = pk2(s1[0], s1[1]); pk.w = pk2(s1[2], s1[3]);
            *(LAS u32x4*)(lds + RL_XC + r * HRS + c8 * 16) = pk;
            *(LAS f32x4*)(XF + r * XFS + c8 * 8) = s0; *(LAS f32x4*)(XF + r * XFS + c8 * 8 + 4) = s1; }
        __syncthreads();
        f32x4 acc[4][4];
#pragma unroll
        for (int q = 0; q < 4; ++q)
#pragma unroll
            for (int rb = 0; rb < 4; ++rb) acc[q][rb] = (f32x4){0.f, 0.f, 0.f, 0.f};
#pragma unroll
        for (int rb = 0; rb < 4; ++rb) { pg8::bf16x8 af[4];
#pragma unroll
            for (int ks = 0; ks < 4; ++ks) af[ks] = *(const LAS pg8::bf16x8*)(lds + RL_XC + (16 * rb + fr) * HRS + ks * 64 + fq * 16);
#pragma unroll
            for (int q = 0; q < 4; ++q)
#pragma unroll
                for (int ks = 0; ks < 4; ++ks) acc[q][rb] = MFMA16(af[ks], Wf[q][ks], acc[q][rb]); }
        const int ch = col_base + 16 * w + fr;
        float xc[4][4];
#pragma unroll
        for (int rb = 0; rb < 4; ++rb)
#pragma unroll
            for (int reg = 0; reg < 4; ++reg) xc[rb][reg] = XF[(16 * rb + 4 * fq + reg) * XFS + 16 * w + fr];
        float hsum[4][4]; unsigned ppk[4][4];
#pragma unroll
        for (int dir = 0; dir < 2; ++dir) {
            const float ba = a.in[I_RGBA][dir * 1024 + ch], bx = a.in[I_RGBX][dir * 1024 + ch], sp = log1pf(expf(-a.in[I_LAM][dir * 1024 + ch]));
            float av[4][4], uv[4][4], hh[4][4], pp[4][4];
#pragma unroll
            for (int rb = 0; rb < 4; ++rb)
#pragma unroll
                for (int reg = 0; reg < 4; ++reg) { const float rr = fsigmoid(acc[2 * dir][rb][reg] + ba), gi = fsigmoid(acc[2 * dir + 1][rb][reg] + bx);
                    const float la = -8.f * rr * sp, y2 = 2.f * la; av[rb][reg] = __expf(la);
                    const float om = y2 > -0.02f ? -y2 * (1.f + y2 * (0.5f + y2 * (1.f / 6.f))) : 1.f - __expf(y2);
                    uv[rb][reg] = __builtin_amdgcn_sqrtf(om) * (gi * xc[rb][reg]); }
            float Aend, Eend;
            if (dir == 0) rg_chunk_scan<false>(av, uv, hh, pp, Aend, Eend, X.lane); else rg_chunk_scan<true>(av, uv, hh, pp, Aend, Eend, X.lane);
            if (fq == 0) AE[((size_t)dir * 128 + b * 64 + c) * 1024 + ch] = make_float2(Aend, Eend);
#pragma unroll
            for (int rb = 0; rb < 4; ++rb)
#pragma unroll
                for (int reg = 0; reg < 4; ++reg) { if (dir == 0) { hsum[rb][reg] = hh[rb][reg]; ppk[rb][reg] = pk2(pp[rb][reg], 0.f) & 0xffffu; }
                    else { hsum[rb][reg] += hh[rb][reg]; ppk[rb][reg] |= pk2(0.f, pp[rb][reg]); } }
        }
#pragma unroll
        for (int rb = 0; rb < 4; ++rb)
#pragma unroll
            for (int reg = 0; reg < 4; ++reg) { const size_t o = (size_t)(row_base + 16 * rb + 4 * fq + reg) * HW + ch; HL[o] = hsum[rb][reg]; PP[o] = ppk[rb][reg]; }
        __syncthreads();
    }
}
__device__ __forceinline__ void ph_rg_carry(const Args& a, const Ctx& X) {
    const float2* AE = (const float2*)(a.ws + WS_AE); float* CIN = (float*)(a.ws + WS_CIN);
    if (X.tid >= 256 && X.tid < 272)
        for (int gid = X.bid * 16 + X.tid - 256; gid < 4096; gid += X.G * 16) {
            const int dir = gid >> 11, b = (gid >> 10) & 1, ch = gid & 1023; float cin = 0.f;
#pragma unroll 8
            for (int cc = 0; cc < 64; ++cc) { const int c = dir ? 63 - cc : cc; const size_t o = ((size_t)dir * 128 + b * 64 + c) * 1024 + ch; const float2 ae = AE[o]; CIN[o] = cin; cin = ae.x * cin + ae.y; }
        }
}
__device__ __forceinline__ void ph_rg_out(const Args& a, const Ctx& X) {
    const float* HL = (const float*)(a.ws + WS_HL); const unsigned* PP = (const unsigned*)(a.ws + WS_PP); const float* CIN = (const float*)(a.ws + WS_CIN);
    const bf16* RGY = (const bf16*)(a.ws + WS_RGY); bf16* RGO = (bf16*)(a.ws + WS_RGO);
    for (size_t i = ((size_t)X.bid * NTHR + X.tid) * 4; i < (size_t)NTOK * HW; i += (size_t)X.G * NTHR * 4) {
        const size_t row = i >> 10; const int ch = (int)(i & 1023); const size_t co = (row >> 6) * 1024 + ch;
        const f32x4 hl = *(const f32x4*)(HL + i), cf = *(const f32x4*)(CIN + co), cb = *(const f32x4*)(CIN + (size_t)128 * 1024 + co); const u32x4 pp = *(const u32x4*)(PP + i); const u32x2 y = *(const u32x2*)(RGY + i);
        const float o0 = (hl[0] + bflo(pp.x) * cf[0] + bfhi(pp.x) * cb[0]) * bflo(y.x), o1 = (hl[1] + bflo(pp.y) * cf[1] + bfhi(pp.y) * cb[1]) * bfhi(y.x);
        const float o2 = (hl[2] + bflo(pp.z) * cf[2] + bfhi(pp.z) * cb[2]) * bflo(y.y), o3 = (hl[3] + bflo(pp.w) * cf[3] + bfhi(pp.w) * cb[3]) * bfhi(y.y);
        u32x2 w; w.x = pk2(o0, o1); w.y = pk2(o2, o3); *(u32x2*)(RGO + i) = w; }
}

template <int MODE>
__device__ __forceinline__ void moe_gemm(const Args& a, const Ctx& X, const int nu, const long Lstart, const int base) {
    constexpr int K = MODE == 1 ? DM : DEX, NT = K / 64, ABUF = 0  , BBUF = 65536  ;
    LAS unsigned char* lds = X.lds;
    constexpr int ldb = MODE == 1 ? DEX : DM;
    const int2* tab = (const int2*)(a.ws + WS_UTAB); const int* rowtok = (const int*)(a.ws + WS_RTOK);
    unsigned* hcnt = (unsigned*)(a.ws + WS_CTL) + CW_HID;
    const int nuX = __builtin_amdgcn_readfirstlane(nu >> 3), rank = __builtin_amdgcn_readfirstlane(X.vb >> 3), xq = __builtin_amdgcn_readfirstlane(X.vb & 7), r3 = nuX & 31, al = 32 - r3; const bool dealt = MODE == 2 && X.G == 256;
#define UNIT_TI(itv, out) do { if (!dealt) { const int L_ = (int)Lstart + (itv) * X.G; out = L_ >= base + nu ? -1 : L_ - base; } \
        else { const int j_ = rank >= r3 ? ((itv) < 2 ? (rank - r3) + al * (itv) : 2 * al + rank + 32 * ((itv) - 2)) : 2 * al + rank + 32 * (itv); out = j_ >= nuX ? -1 : 8 * j_ + xq; } } while (0)
    f32x4 rb0[8]; bool pre = false;
    for (int it = 0; ; ++it) {
        int ti; UNIT_TI(it, ti); if (ti < 0) break;
        int tin; UNIT_TI(it + 1, tin); const bool hn = tin >= 0;
        const int2 tt = tab[ti]; const int pm = __builtin_amdgcn_readfirstlane(tt.x), e = __builtin_amdgcn_readfirstlane(tt.y >> 3), pnl = __builtin_amdgcn_readfirstlane(tt.y & 7);
        const int2 ttn = tab[hn ? tin : ti]; const int en = __builtin_amdgcn_readfirstlane(ttn.y >> 3), pnln = __builtin_amdgcn_readfirstlane(ttn.y & 7);
        if (MODE == 2) {
            if (X.wave == 0) { unsigned sp = 0;
                while ((unsigned)__builtin_amdgcn_readfirstlane((int)__hip_atomic_load(hcnt + pm, __ATOMIC_RELAXED, __HIP_MEMORY_SCOPE_AGENT)) < 64u) { __builtin_amdgcn_s_sleep(2); if (++sp > (1u << 22)) break; }
                __builtin_amdgcn_fence(__ATOMIC_ACQUIRE, "agent"); asm volatile("s_waitcnt vmcnt(0)" ::: "memory"); }
            __syncthreads(); }
        unsigned z0 = 0u; asm volatile("" : "+v"(z0)); const int ln = (int)__builtin_amdgcn_mbcnt_hi(~0u, __builtin_amdgcn_mbcnt_lo(~0u, z0));
        int aoff, boff, aR0, aC0, bbase; unsigned bofs;
        { const int tid = X.wave * 64 + ln, wm = X.wave >> 2, wn = X.wave & 3, fr = ln & 15, fq = ln >> 4;
          aoff = pg8::lds_byte(wm * 128 + fr, fq * 8); boff = (wn * 4) * 2048 + fr * 64 + ((fq ^ ((fr >> 2) & 3)) * 16);
          pg8::stage_rc(tid * 16, aR0, aC0);
          int kgq, n0;
          if (MODE == 1) { const int mcol = 4 * (ln & 31); kgq = 2 * (X.wave >> 1) + (ln >> 5); n0 = 64 * (mcol >> 5) + 32 * (X.wave & 1) + 16 * ((mcol >> 2) & 1) + 4 * ((mcol >> 3) & 3); bofs = (unsigned)((8 * kgq) * DEX + mcol) * 4u; }
          else { kgq = X.wave; const int c0 = 4 * ln; bofs = (unsigned)((8 * kgq) * DM + c0) * 4u;
            n0 = (c0 & ~31) + 16 * ((c0 >> 2) & 1) + 4 * ((c0 >> 3) & 3); }
          bbase = ((n0 >> 4) * 2 + (kgq >> 2)) * 1024 + (n0 & 15) * 64 + (((kgq & 3) ^ ((n0 >> 2) & 3)) * 16); }
        const unsigned char* abase = MODE == 1 ? a.ws + WS_H : a.ws + WS_HID;
        unsigned aofs[4];
#pragma unroll
        for (int i = 0; i < 4; ++i) { const int r = pm * 256 + aR0 + 64 * i;
            aofs[i] = MODE == 1 ? (unsigned)rowtok[r] * (DM * 2) + aC0 * 2 : (unsigned)r * (DEX * 2) + aC0 * 2; }
        const unsigned char* bsrc = MODE == 1 ? (const unsigned char*)(a.in[(X.wave & 1) ? I_WUP : I_WGATE] + (size_t)e * DM * DEX + pnl * 128)
                                              : (const unsigned char*)(a.in[I_WDOWN] + (size_t)e * DEX * DM + pnl * 256);
        f32x4 acc[8][4];
#pragma unroll
        for (int m = 0; m < 8; ++m)
#pragma unroll
            for (int n = 0; n < 4; ++n) acc[m][n] = (f32x4){0.f, 0.f, 0.f, 0.f};
        const __amdgpu_buffer_rsrc_t brsrc = __builtin_amdgcn_make_buffer_rsrc((void*)bsrc, 0, 0x7fffffff, 0x00020000);
        const unsigned char* bsrcn = MODE == 1 ? (const unsigned char*)(a.in[(X.wave & 1) ? I_WUP : I_WGATE] + (size_t)en * DM * DEX + pnln * 128)
                                               : (const unsigned char*)(a.in[I_WDOWN] + (size_t)en * DEX * DM + pnln * 256);
        const __amdgpu_buffer_rsrc_t brsrcn = __builtin_amdgcn_make_buffer_rsrc((void*)bsrcn, 0, 0x7fffffff, 0x00020000);
        LAS unsigned char* const adst = lds + ABUF + X.wave * 1024;
        const __amdgpu_buffer_rsrc_t arsrc = __builtin_amdgcn_make_buffer_rsrc((void*)abase, 0, 0x7fffffff, 0x00020000);
#define MOE_DMA_A(t, buf) do { _Pragma("unroll") for (int i = 0; i < 4; ++i) \
        __builtin_amdgcn_raw_ptr_buffer_load_lds(arsrc, (LAS unsigned*)(adst + (buf) * 32768 + i * 8192), 16, (int)aofs[i], (t) * 128, 0, 0); } while (0)
#define MOE_LOAD(rb, t) do { _Pragma("unroll") for (int j = 0; j < 8; ++j) rb[j] = __builtin_bit_cast(f32x4, __builtin_amdgcn_raw_buffer_load_b128(brsrc, (int)bofs, ((t) * 64 + j) * ldb * 4, 0)); } while (0)
#define MOE_LOADN(rb) do { _Pragma("unroll") for (int j = 0; j < 8; ++j) rb[j] = __builtin_bit_cast(f32x4, __builtin_amdgcn_raw_buffer_load_b128(brsrcn, (int)bofs, j * ldb * 4, 0)); } while (0)
#define MOE_PK(rb, c) (u32x4){pk2(rb[0][c], rb[1][c]), pk2(rb[2][c], rb[3][c]), pk2(rb[4][c], rb[5][c]), pk2(rb[6][c], rb[7][c])}
#define MOE_STORE(rb, buf) do { const u32x4 p0 = MOE_PK(rb, 0), p1 = MOE_PK(rb, 1), p2 = MOE_PK(rb, 2), p3 = MOE_PK(rb, 3); LAS unsigned char* bw = lds + BBUF + (buf) * 32768 + bbase; \
        *(LAS u32x4*)(bw) = p0; *(LAS u32x4*)(bw + 64) = p1; *(LAS u32x4*)(bw + 128) = p2; *(LAS u32x4*)(bw + 192) = p3; } while (0)
#define MOE_FRAGB(bs, k, buf) do { _Pragma("unroll") for (int n = 0; n < 4; ++n) bs[n] = *(const LAS pg8::bf16x8*)(lds + BBUF + (buf) * 32768 + boff + n * 2048 + (k) * 1024); } while (0)
#define MOE_FRAGA(as, k, buf, m0) do { _Pragma("unroll") for (int m = 0; m < 2; ++m) as[m] = *(const LAS pg8::bf16x8*)(lds + ABUF + (buf) * 32768 + aoff + ((m0) + m) * 2048 + (k) * 1024); } while (0)
#define MOE_MMA(bs, as, m0) do { _Pragma("unroll") for (int m = 0; m < 2; ++m) _Pragma("unroll") for (int n = 0; n < 4; ++n) acc[(m0) + m][n] = MFMA16(bs[n], as[m], acc[(m0) + m][n]); } while (0)
#define MOE_SB() __builtin_amdgcn_sched_barrier(0)
#define MOE_BAR(nv) do { asm volatile("s_waitcnt vmcnt(" #nv ") lgkmcnt(0)" ::: "memory"); __builtin_amdgcn_s_barrier(); asm volatile("" ::: "memory"); } while (0)
#define MOE_STAGE(tt, bufc) do { if ((tt) + 1 < NT) MOE_STORE(rb0, (bufc) ^ 1); MOE_SB(); if ((tt) + 2 < NT) MOE_LOAD(rb0, (tt) + 2); else if ((tt) + 2 == NT && hn) MOE_LOADN(rb0); MOE_SB(); } while (0)
#define MOE_STEP(tt, bufc) do { MOE_FRAGB(b0, 0, bufc); MOE_FRAGA(a0, 0, bufc, 0); MOE_SB(); \
        if ((tt) + 1 < NT) MOE_DMA_A((tt) + 1, (bufc) ^ 1); MOE_SB(); if (!late) MOE_STAGE(tt, bufc); MOE_SB(); \
        MOE_FRAGA(a1, 0, bufc, 2); MOE_MMA(b0, a0, 0); MOE_SB(); MOE_FRAGA(a0, 0, bufc, 4); MOE_MMA(b0, a1, 2); MOE_SB(); MOE_FRAGA(a1, 0, bufc, 6); MOE_MMA(b0, a0, 4); MOE_SB(); \
        MOE_FRAGB(b1, 1, bufc); MOE_FRAGA(a0, 1, bufc, 0); MOE_MMA(b0, a1, 6); MOE_SB(); \
        if (late) MOE_STAGE(tt, bufc); MOE_SB(); \
        MOE_FRAGA(a1, 1, bufc, 2); MOE_MMA(b1, a0, 0); MOE_SB(); MOE_FRAGA(a0, 1, bufc, 4); MOE_MMA(b1, a1, 2); MOE_SB(); MOE_FRAGA(a1, 1, bufc, 6); MOE_MMA(b1, a0, 4); MOE_SB(); \
        MOE_MMA(b1, a1, 6); MOE_SB(); \
        if ((tt) + 2 < NT || hn) MOE_BAR(8); else MOE_BAR(0); } while (0)
        const bool late = X.wave >= 4;
        pg8::bf16x8 a0[2], a1[2], b0[4], b1[4];
        if (!pre) MOE_LOAD(rb0, 0); MOE_DMA_A(0, 0); MOE_STORE(rb0, 0); __builtin_amdgcn_sched_barrier(0); MOE_LOAD(rb0, 1); __builtin_amdgcn_sched_barrier(0); pre = hn;
        MOE_BAR(8);
        for (int t = 0; t < NT; t += 2) { MOE_STEP(t, 0); MOE_STEP(t + 1, 1); }
#undef MOE_DMA_A
#undef MOE_STAGE
#undef MOE_BAR
#undef MOE_FRAGA
#undef MOE_SB
#undef MOE_FRAGB
#undef MOE_MMA
#undef MOE_STEP
#undef MOE_LOAD
#undef MOE_LOADN
#undef MOE_PK
#undef MOE_STORE
        unsigned z1 = 0u; asm volatile("" : "+v"(z1)); const int l2 = (int)__builtin_amdgcn_mbcnt_hi(~0u, __builtin_amdgcn_mbcnt_lo(~0u, z1)); const int wm = X.wave >> 2, wn = X.wave & 3, fr = l2 & 15, fq = l2 >> 4;
        const size_t row0 = (size_t)pm * 256 + 128 * wm + fr;
        if (MODE == 1) { bf16* HID = (bf16*)(a.ws + WS_HID);
#pragma unroll
            for (int m = 0; m < 8; ++m) { const f32x4 g0 = acc[m][0], g1 = acc[m][1], u0 = acc[m][2], u1 = acc[m][3];
                u32x4 wv; wv.x = pk2(fsilu(g0[0]) * u0[0], fsilu(g0[1]) * u0[1]); wv.y = pk2(fsilu(g0[2]) * u0[2], fsilu(g0[3]) * u0[3]);
                wv.z = pk2(fsilu(g1[0]) * u1[0], fsilu(g1[1]) * u1[1]); wv.w = pk2(fsilu(g1[2]) * u1[2], fsilu(g1[3]) * u1[3]);
                bf16* hp = HID + (row0 + 16 * m) * DEX + pnl * 128 + 32 * wn + 8 * fq;
                asm volatile("global_store_dwordx4 %0, %1, off sc1" :: "v"(hp), "v"(wv) : "memory"); }
            asm volatile("s_waitcnt vmcnt(0)" ::: "memory");
            if (l2 == 0) __hip_atomic_fetch_add(hcnt + pm, 1u, __ATOMIC_RELAXED, __HIP_MEMORY_SCOPE_AGENT); }
        else { bf16* Y = (bf16*)(a.ws + WS_Y);
#pragma unroll
            for (int m = 0; m < 8; ++m)
#pragma unroll
                for (int p = 0; p < 2; ++p) { const f32x4 v = acc[m][2 * p], w = acc[m][2 * p + 1]; u32x4 wv; wv.x = pk2(v[0], v[1]); wv.y = pk2(v[2], v[3]); wv.z = pk2(w[0], w[1]); wv.w = pk2(w[2], w[3]);
                    *(u32x4*)(Y + (row0 + 16 * m) * DM + pnl * 256 + 64 * wn + 32 * p + 8 * fq) = wv; } }
    }
}

__device__ __forceinline__ void ph_route_prep(const Args& a, const Ctx& X) {
    const float* mod = (const float*)(a.ws + WS_MOD); f32x4* WR2 = (f32x4*)(a.ws + WS_WR2); float* B2 = (float*)(a.ws + WS_BIAS2);
    { u32x4* WH = (u32x4*)(a.ws + WS_WR2);
      for (int idx = X.bid * NTHR + X.tid; idx < 2 * 64 * 3 * 64; idx += X.G * NTHR) {
        const int lane = idx & 63, nb = (idx >> 6) % 3, s = (idx / 192) & 63, b = idx / (192 * 64), n = 16 * nb + (lane & 15), k0 = 32 * s + 8 * (lane >> 4);
        float w[8];
#pragma unroll
        for (int j = 0; j < 8; ++j) { const int k = k0 + j; const float wv = n < 4 ? a.in[I_WGRP][k * 4 + n] : n < 36 ? a.in[I_WRTR][k * 32 + n - 4] : 0.f;
            w[j] = wv * a.in[I_NORM2][k] * (1.f + mod[b * 12288 + 4 * DM + k]); }
        u32x4 hi, lo;
#pragma unroll
        for (int p = 0; p < 4; ++p) { const unsigned h = pk2(w[2 * p], w[2 * p + 1]); hi[p] = h; lo[p] = pk2(w[2 * p] - bflo(h), w[2 * p + 1] - bfhi(h)); }
        WH[idx] = hi; WH[idx + 24576] = lo; } }
    for (int p = X.gw; p < 96; p += X.NGW) { const int b = p / 48, n = p % 48; float s = 0.f;
        if (n < 36) { const float* wp = n < 4 ? a.in[I_WGRP] + n : a.in[I_WRTR] + n - 4; const int ws_ = n < 4 ? 4 : 32;
#pragma unroll
            for (int i = 0; i < 32; ++i) { const int k = X.lane + 64 * i; s += mod[b * 12288 + 3 * DM + k] * wp[(size_t)k * ws_]; } }
        s = wave_sum(s); if (X.lane == 0) B2[p] = s; }
}
__device__ __forceinline__ void ph_route2(const Args& a, const Ctx& X) {
    const float* X1 = (const float*)(a.ws + WS_X1); const float* mod = (const float*)(a.ws + WS_MOD); bf16* H = (bf16*)(a.ws + WS_H);
    const f32x4* WR2 = (const f32x4*)(a.ws + WS_WR2); const float* B2 = (const float*)(a.ws + WS_BIAS2);
    int* toke = (int*)(a.ws + WS_TOKE); float* tokw = (float*)(a.ws + WS_TOKW);
    LAS float* PART = (LAS float*)X.lds;
    LAS float* SSP = PART + 8 * 16 * 48;
    LAS float* RSTD = SSP + 128;
    const int i = X.lane & 15, g = X.lane >> 4, tl = X.wave >> 2, kq = X.wave & 3;
    for (int tp = X.bid; tp < NTOK / 32; tp += X.G) {
        const int tok0 = tp * 32 + tl * 16, b = tok0 >> 12;
        f32x4 acc[3];
#pragma unroll
        for (int nb = 0; nb < 3; ++nb) acc[nb] = (f32x4){0.f, 0.f, 0.f, 0.f};
        float ss = 0.f;
        const float* xr = X1 + (size_t)(tok0 + i) * DM + kq * 512 + 8 * g; const u32x4* wh = (const u32x4*)(a.ws + WS_WR2) + (size_t)((b * 64 + kq * 16) * 3) * 64 + X.lane;
#pragma unroll 4
        for (int s = 0; s < 16; ++s) { const f32x4 x0 = *(const f32x4*)(xr + 32 * s), x1v = *(const f32x4*)(xr + 32 * s + 4);
            ss += ((x0[0] * x0[0] + x0[1] * x0[1]) + (x0[2] * x0[2] + x0[3] * x0[3])) + ((x1v[0] * x1v[0] + x1v[1] * x1v[1]) + (x1v[2] * x1v[2] + x1v[3] * x1v[3]));
            u32x4 xh, xl;
            xh[0] = pk2(x0[0], x0[1]); xh[1] = pk2(x0[2], x0[3]); xh[2] = pk2(x1v[0], x1v[1]); xh[3] = pk2(x1v[2], x1v[3]);
            xl[0] = pk2(x0[0] - bflo(xh[0]), x0[1] - bfhi(xh[0])); xl[1] = pk2(x0[2] - bflo(xh[1]), x0[3] - bfhi(xh[1]));
            xl[2] = pk2(x1v[0] - bflo(xh[2]), x1v[1] - bfhi(xh[2])); xl[3] = pk2(x1v[2] - bflo(xh[3]), x1v[3] - bfhi(xh[3]));
            const pg8::bf16x8 XH = __builtin_bit_cast(pg8::bf16x8, xh), XL = __builtin_bit_cast(pg8::bf16x8, xl);
#pragma unroll
            for (int nb = 0; nb < 3; ++nb) { const pg8::bf16x8 WHf = __builtin_bit_cast(pg8::bf16x8, wh[(s * 3 + nb) * 64]), WLf = __builtin_bit_cast(pg8::bf16x8, wh[(s * 3 + nb) * 64 + 24576]);
                acc[nb] = __builtin_amdgcn_mfma_f32_16x16x32_bf16(XL, WHf, acc[nb], 0, 0, 0); acc[nb] = __builtin_amdgcn_mfma_f32_16x16x32_bf16(XH, WLf, acc[nb], 0, 0, 0);
                acc[nb] = __builtin_amdgcn_mfma_f32_16x16x32_bf16(XH, WHf, acc[nb], 0, 0, 0); } }
        ss += __shfl_xor(ss, 16); ss += __shfl_xor(ss, 32);
#pragma unroll
        for (int nb = 0; nb < 3; ++nb)
#pragma unroll
            for (int r = 0; r < 4; ++r) PART[(X.wave * 16 + 4 * g + r) * 48 + 16 * nb + i] = acc[nb][r];
        if (g == 0) SSP[X.wave * 16 + i] = ss;
        __syncthreads();
        if (X.tid < 32) { const int tq = X.tid >> 4, tk = X.tid & 15, row = tp * 32 + X.tid;
            const float rstd = rsqrtf(((SSP[(tq * 4) * 16 + tk] + SSP[(tq * 4 + 1) * 16 + tk]) + (SSP[(tq * 4 + 2) * 16 + tk] + SSP[(tq * 4 + 3) * 16 + tk])) * (1.f / DM) + EPS);
            RSTD[X.tid] = rstd;
            float lg[36];
#pragma unroll
            for (int n = 0; n < 36; ++n) lg[n] = rstd * ((PART[((tq * 4) * 16 + tk) * 48 + n] + PART[((tq * 4 + 1) * 16 + tk) * 48 + n]) + (PART[((tq * 4 + 2) * 16 + tk) * 48 + n] + PART[((tq * 4 + 3) * 16 + tk) * 48 + n])) + B2[b * 48 + n];
            int gi = 0; float gmax = lg[0];
#pragma unroll
            for (int q = 1; q < 4; ++q) if (lg[q] > gmax) { gmax = lg[q]; gi = q; }
            float den = 0.f;
#pragma unroll
            for (int q = 0; q < 4; ++q) den += expf(lg[q] - gmax);
            const float pg = 1.f / den;
            float sl[8];
#pragma unroll
            for (int q = 0; q < 8; ++q) sl[q] = gi == 0 ? lg[4 + q] : gi == 1 ? lg[12 + q] : gi == 2 ? lg[20 + q] : lg[28 + q];
            int i0 = 0; float v0 = sl[0];
#pragma unroll
            for (int q = 1; q < 8; ++q) if (sl[q] > v0) { v0 = sl[q]; i0 = q; }
            int i1 = (i0 + 1) & 7; float v1 = -3.0e38f;
#pragma unroll
            for (int q = 0; q < 8; ++q) if (q != i0 && sl[q] > v1) { v1 = sl[q]; i1 = q; }
            const float e = expf(v1 - v0);
            toke[row * 2] = gi * 8 + i0; toke[row * 2 + 1] = gi * 8 + i1; tokw[row * 2] = pg / (1.f + e); tokw[row * 2 + 1] = pg * e / (1.f + e); }
        __syncthreads();
        for (int q = 0; q < 4; ++q) { const int tt = X.wave * 4 + q, row = tp * 32 + tt; f32x4 v[8];
#pragma unroll
            for (int j = 0; j < 8; ++j) v[j] = *(const f32x4*)(X1 + (size_t)row * DM + 4 * X.lane + 256 * j);
            const float* mb = mod + (row >> 12) * 12288;
            row_modulate(v, RSTD[tt], a.in[I_NORM2], mb + 3 * DM, mb + 4 * DM, X.lane);
#pragma unroll
            for (int j = 0; j < 8; ++j) { u32x2 w; w.x = pk2(v[j][0], v[j][1]); w.y = pk2(v[j][2], v[j][3]); *(u32x2*)(H + (size_t)row * DM + 4 * X.lane + 256 * j) = w; } }
        __syncthreads();
    }
}
__device__ __forceinline__ void ph_sort(const Args& a, const Ctx& X) {
    unsigned* ctl = (unsigned*)(a.ws + WS_CTL); const int* toke = (const int*)(a.ws + WS_TOKE); int* tokp = (int*)(a.ws + WS_TOKP); int* rowtok = (int*)(a.ws + WS_RTOK);
    LAS int* tot = (LAS int*)X.lds;
    LAS int* pre = tot + 32;
    LAS int* offs = tot + 64;
    LAS int* nbk = tot + 96;
    LAS int* lpos = tot + 128;
    const int RPB = (NTOK + X.G - 1) / X.G, r_lo = X.bid * RPB, r_hi = (r_lo + RPB < NTOK) ? r_lo + RPB : NTOK;
    if (X.tid < 64) tot[X.tid] = 0;
    __syncthreads();
    for (int j = X.tid; j < NTOK * 2; j += NTHR) { const int e = toke[j]; atomicAdd((int*)&tot[e], 1); if ((j >> 1) < r_lo) atomicAdd((int*)&pre[e], 1); }
    __syncthreads();
    if (X.tid == 0) { int o = 0; for (int e = 0; e < NEXP; ++e) { offs[e] = o; const int nb = (tot[e] + 255) >> 8; nbk[e] = nb; o += nb * 256; }
        if (X.bid == 0) ((int*)ctl)[CW_NU] = (o >> 8) * 8;
        for (int e = 0; e < NEXP; ++e) pre[e] += offs[e];
        for (int r = r_lo; r < r_hi; ++r) for (int k = 0; k < 2; ++k) { const int e = toke[r * 2 + k]; lpos[(r - r_lo) * 2 + k] = pre[e]++; } }
    __syncthreads();
    if (X.bid == 0 && X.tid < 256) { int2* tab = (int2*)(a.ws + WS_UTAB); const int x = X.tid & 7, e = X.tid >> 3, nb = nbk[e], pm0 = offs[e] >> 8;
        for (int rb = 0; rb < nb; ++rb) tab[8 * (pm0 + rb) + x] = make_int2(pm0 + rb, e * 8 + x); }
    for (int e = X.bid; e < NEXP; e += X.G) for (int i = tot[e] + X.tid; i < nbk[e] * 256; i += NTHR) rowtok[offs[e] + i] = 0;
    for (int i = X.tid; i < (r_hi - r_lo) * 2; i += NTHR) { const int pos = lpos[i]; tokp[r_lo * 2 + i] = pos; rowtok[pos] = r_lo + (i >> 1); }
}
__device__ __forceinline__ void ph_final(const Args& a, const Ctx& X) {
    const float* X1 = (const float*)(a.ws + WS_X1); const float* mod = (const float*)(a.ws + WS_MOD); const bf16* Y = (const bf16*)(a.ws + WS_Y);
    const float* tokw = (const float*)(a.ws + WS_TOKW); const int* tokp = (const int*)(a.ws + WS_TOKP);
    for (int row = X.gw; row < NTOK; row += X.NGW) {
        const float w0 = tokw[row * 2], w1 = tokw[row * 2 + 1]; const bf16* y0 = Y + (size_t)tokp[row * 2] * DM; const bf16* y1 = Y + (size_t)tokp[row * 2 + 1] * DM;
        const float* g2 = mod + (row >> 12) * 12288 + 5 * DM;
        f32x4 v[8]; float ss = 0.f;
#pragma unroll
        for (int j = 0; j < 8; ++j) { const int d = 4 * X.lane + 256 * j; const f32x4 xv = *(const f32x4*)(X1 + (size_t)row * DM + d), gv = *(const f32x4*)(g2 + d);
            const u32x2 p = *(const u32x2*)(y0 + d), q = *(const u32x2*)(y1 + d);
            f32x4 m; m[0] = w0 * bflo(p.x) + w1 * bflo(q.x); m[1] = w0 * bfhi(p.x) + w1 * bfhi(q.x); m[2] = w0 * bflo(p.y) + w1 * bflo(q.y); m[3] = w0 * bfhi(p.y) + w1 * bfhi(q.y);
            v[j] = xv + gv * m; ss += (v[j][0] * v[j][0] + v[j][1] * v[j][1]) + (v[j][2] * v[j][2] + v[j][3] * v[j][3]); }
        const float rstd = rsqrtf(wave_sum(ss) * (1.f / DM) + EPS);
#pragma unroll
        for (int j = 0; j < 8; ++j) { const int d = 4 * X.lane + 256 * j; *(f32x4*)(a.out + (size_t)row * DM + d) = v[j] * rstd * *(const f32x4*)(a.in[I_FNORM] + d); }
    }
}

__device__ __forceinline__ Ctx mkctx(LAS unsigned char* lds, int vb, int wave) { Ctx X; unsigned z = 0u; asm volatile("" : "+v"(z)); int l = (int)__builtin_amdgcn_mbcnt_hi(~0u, __builtin_amdgcn_mbcnt_lo(~0u, z)); asm volatile("" : "+v"(l));
    X.lds = lds; X.lane = l; X.wave = wave; X.tid = wave * 64 + l; X.bid = blockIdx.x; X.G = gridDim.x; X.gw = X.bid * NWAVES + X.wave; X.NGW = X.G * NWAVES; X.vb = vb; return X; }
constexpr int N_PHASES = 13;
__global__ void __launch_bounds__(NTHR, 2) hybrid_fwd(Args args) {
    extern __shared__ __attribute__((aligned(16))) unsigned char lds_raw[];
    Ctx X0; X0.lds = (LAS unsigned char*)lds_raw; X0.tid = threadIdx.x; X0.lane = X0.tid & 63; X0.wave = __builtin_amdgcn_readfirstlane(X0.tid >> 6);
    X0.bid = blockIdx.x; X0.G = gridDim.x; X0.gw = X0.bid * NWAVES + X0.wave; X0.NGW = X0.G * NWAVES;
    unsigned char* ws = args.ws;
    volatile LAS unsigned* MISC = (volatile LAS unsigned*)(X0.lds + MISC_OFF);
    for (int u = X0.tid; u < (LDS_BYTES - RING_BYTES) / 4; u += NTHR) ((LAS unsigned*)(X0.lds + RING_BYTES))[u] = 0u;
    __syncthreads();
    XcdBarrier bar; bar.bar = (unsigned*)(ws + WS_CTL) + CW_BAR; bar.x = 0; bar.st = nullptr;
    if (MK_N_LAUNCHES == 1) bar = xcd_barrier_post((unsigned*)(ws + WS_CTL) + CW_BAR, MISC + 8);
    X0.vb = X0.bid;
    if (MK_N_LAUNCHES == 1 && X0.tid == 0) { const unsigned xcc = xb_xcc_id(); MISC[12] = xcc; MISC[13] = xb_add((unsigned*)(ws + WS_CTL) + CW_RANK + 64 * xcc, 1u); }
    const int lo = args.ph_lo, hi = args.ph_hi, wave_s0 = X0.wave;
#define IN(k) (lo <= (k) && (k) < hi)
#define SEAM(k) do { if (IN(k) && IN((k) + 1)) xcd_barrier(bar, wave_s0 * 64 + (int)__builtin_amdgcn_mbcnt_hi(~0u, __builtin_amdgcn_mbcnt_lo(~0u, 0u))); } while (0)

    LAS unsigned char* const lds0 = X0.lds; const int wave_s = X0.wave;
    if (IN(0)) { ph_prologue(args, X0); }
    if (IN(1)) { const Ctx X = mkctx(lds0, X0.vb, wave_s);
        if (MK_N_LAUNCHES == 1) { if (X.wave == 0) { unsigned sp = 0; while (xb_ld((unsigned*)(ws + WS_CTL) + CW_MODC) < 192u) { __builtin_amdgcn_s_sleep(4); if (++sp > (1u << 22)) break; }
                __builtin_amdgcn_fence(__ATOMIC_ACQUIRE, "agent"); asm volatile("s_waitcnt vmcnt(0)" ::: "memory"); }
            __syncthreads(); }
        ph_norm1(args, X); if (!late_convert(X.G)) ph_route_prep(args, X); } SEAM(1);
    if (MK_N_LAUNCHES == 1) {
        unsigned* barw = (unsigned*)(ws + WS_CTL) + CW_BAR; bool uni = (X0.G % 8) == 0;
        for (int j = 0; j < 16; ++j) { const unsigned cnt = xb_ld(barw + XB_XCNT(j)); uni = uni && (cnt == (j < 8 ? (unsigned)X0.G / 8u : 0u)); }
        __syncthreads();
        if (uni) X0.vb = __builtin_amdgcn_readfirstlane((int)(MISC[13] * 8u + MISC[12]));
    }
    const int vb_ = X0.vb;
    if (IN(2)) { const Ctx X = mkctx(lds0, vb_, wave_s); pg8::Gemm g{(const bf16*)(ws + WS_H), (const bf16*)(ws + WS_WIN), NTOK, INC, DM}; pg8::StaticOrder S; S.init(NTOK, INC, X.G, X.vb);
        EpiIn E{ws, (const float*)(ws + WS_LB)}; pg8::gemm_phase<EpiIn, pg8::StaticOrder, true, true>(X.lds, g, S, E, X.tid);
        if (late_convert(X.G)) { const int rem = S.nwg % X.G, nsh = X.G - rem;
            if (X.vb >= rem) { convert_items(args, X.lds, X.wave, X.lane, CV_I0, CV_ALL, (X.vb - rem) * NWAVES + X.wave, nsh * NWAVES);
                Ctx Xs = X; Xs.bid = X.vb - rem; Xs.G = nsh; Xs.gw = Xs.bid * NWAVES + X.wave; Xs.NGW = nsh * NWAVES; ph_route_prep(args, Xs); } } } SEAM(2);
    if (IN(3)) { const Ctx X = mkctx(lds0, vb_, wave_s); ph_rg_local(args, X); ph_hg_local(args, X); } SEAM(3);
    if (IN(4)) { const Ctx X = mkctx(lds0, vb_, wave_s); ph_hg_scan(args, X); ph_rg_carry(args, X); } SEAM(4);
    if (IN(5)) { const Ctx X = mkctx(lds0, vb_, wave_s); ph_rg_out(args, X); ph_hg_out(args, X); } SEAM(5);
    if (IN(6)) { const Ctx X = mkctx(lds0, vb_, wave_s);
        { pg8::Gemm g{(const bf16*)(ws + WS_HGO), (const bf16*)(ws + WS_WPA), NTOK, DM, HW, (const bf16*)(ws + WS_RGO), (const bf16*)(ws + WS_WPB)}; pg8::TwoOrder S; S.s.init(NTOK, DM, X.G, X.vb);
          EpiGateBoth E{{(const bf16*)(ws + WS_SGA), nullptr, (bf16*)(ws + WS_YA), DM}, {(const bf16*)(ws + WS_SGB), (const bf16*)(ws + WS_YA), (bf16*)(ws + WS_MRG), DM}};
          pg8::gemm_phase<EpiGateBoth, pg8::TwoOrder, true, true>(X.lds, g, S, E, X.tid); } } SEAM(7);
    if (IN(8)) { const Ctx X = mkctx(lds0, vb_, wave_s); pg8::Gemm g{(const bf16*)(ws + WS_MRG), (const bf16*)(ws + WS_WOUT), NTOK, DM, DM}; pg8::StaticOrder S; S.init(NTOK, DM, X.G, X.vb);
        EpiX1 E{args.in[I_X], (const float*)(ws + WS_MOD), (float*)(ws + WS_X1)}; pg8::gemm_phase<EpiX1, pg8::StaticOrder, true, true>(X.lds, g, S, E, X.tid); } SEAM(8);
    if (IN(9)) { const Ctx X = mkctx(lds0, vb_, wave_s); ph_route2(args, X); } SEAM(9);
    if (IN(10)) { const Ctx X = mkctx(lds0, vb_, wave_s); ph_sort(args, X); } SEAM(10);
    if (IN(11)) { const Ctx X = mkctx(lds0, vb_, wave_s); const int nu = __builtin_amdgcn_readfirstlane((int)xb_ld((unsigned*)(ws + WS_CTL) + CW_NU));
        moe_gemm<1>(args, X, nu, X.vb, 0);
        const long L2 = X.vb + (long)((nu - X.vb + X.G - 1) / X.G) * X.G;
        const Ctx Xd = mkctx(lds0, vb_, wave_s);
        moe_gemm<2>(args, Xd, nu, L2 < nu ? nu + 0 : L2, nu); } SEAM(11);
    if (IN(12)) { const Ctx X = mkctx(lds0, vb_, wave_s); ph_final(args, X); }
#undef IN
#undef SEAM
}

extern "C" void kernel_launch(void* const* d_in, const int* in_sizes, int n_in, void* d_out, int out_size, void* d_ws, size_t ws_size, hipStream_t stream) {
    static int grid = 0;
    if (grid == 0) {
        if (n_in != 25 || out_size != NTOK * DM || ws_size < WS_END) { fprintf(stderr, "kernel_launch: unexpected problem (n_in %d, out %d, ws %zu < %zu)\n", n_in, out_size, ws_size, (size_t)WS_END); grid = -1; return; }
        int dev = 0, cus = 0, per_cu = 0;
        if (hipGetDevice(&dev) != hipSuccess || hipDeviceGetAttribute(&cus, hipDeviceAttributeMultiprocessorCount, dev) != hipSuccess) { grid = -1; return; }
        if (hipFuncSetAttribute((const void*)hybrid_fwd, hipFuncAttributeMaxDynamicSharedMemorySize, LDS_BYTES) != hipSuccess) { fprintf(stderr, "kernel_launch: hipFuncSetAttribute failed\n"); grid = -1; return; }
        if (hipOccupancyMaxActiveBlocksPerMultiprocessor(&per_cu, (const void*)hybrid_fwd, NTHR, LDS_BYTES) != hipSuccess || per_cu < 1) fprintf(stderr, "kernel_launch: occupancy query says %d\n", per_cu);
        (void)hipGetLastError();
        grid = cus;
    }
    if (grid < 0) return;
    if (hipMemsetAsync((char*)d_ws + WS_CTL, 0, CTL_ZERO_BYTES, stream) != hipSuccess) return;
    Args a{};
    for (int i = 0; i < 25; ++i) a.in[i] = (const float*)d_in[i];
    a.out = (float*)d_out; a.ws = (unsigned char*)d_ws;
    if (MK_N_LAUNCHES == 1) { a.ph_lo = 0; a.ph_hi = N_PHASES; hipLaunchKernelGGL(hybrid_fwd, dim3(grid), dim3(NTHR), LDS_BYTES, stream, a); }
    else for (int p = 0; p < N_PHASES; ++p) { a.ph_lo = p; a.ph_hi = p + 1; hipLaunchKernelGGL(hybrid_fwd, dim3(grid), dim3(NTHR), LDS_BYTES, stream, a); }
}
```
